# Optimizing an MI355X kernel written in HIP

```python
import math
import jax
import jax.numpy as jnp
from jax import lax
import numpy as np

D_MODEL = 1024
BATCH = 32
SEQ = 256
DEPTH = 2
DEC_BATCH = 4
DEC_SEQ = 4096
PAST_LEN = 512

GRID_W = 64
D_MIX = D_MODEL
GROUP_W = D_MIX // 4
ATT_HEADS = 4
ATT_KV_HEADS = 2
ATT_HEAD_DIM = GROUP_W // ATT_HEADS
WINDOW = 128
BLOCK = 128
DIF_HEADS = 4
DIF_V_DIM = GROUP_W // DIF_HEADS
DIF_QK_DIM = DIF_V_DIM // 2
HY_CH = GROUP_W
HY_STREAMS = 3
FILT_BANDS = 16
FILT_EMB = 1 + 2 * FILT_BANDS
FILT_HIDDEN = 64
HY_DECAY_TARGET = 1e-2
HY_FAST_DECAY = 0.3
HY_SLOW_DECAY = 1.5
HY_MIN_DECAY = math.log(HY_DECAY_TARGET) / HY_SLOW_DECAY
HY_MAX_DECAY = math.log(HY_DECAY_TARGET) / HY_FAST_DECAY
FN_GROUPS = 4
FN_GROUP_CH = GROUP_W // FN_GROUPS
ROPE_BASE = 10000.0
EPS = 1e-6
NEG_INF = -1e30

SPLIT_SIZES = (ATT_HEADS * ATT_HEAD_DIM, ATT_KV_HEADS * ATT_HEAD_DIM, ATT_KV_HEADS * ATT_HEAD_DIM, GROUP_W,
               2 * DIF_HEADS * DIF_QK_DIM, 2 * DIF_HEADS * DIF_QK_DIM, DIF_HEADS * DIF_V_DIM, GROUP_W,
               HY_STREAMS * HY_CH, GROUP_W,
               GROUP_W, GROUP_W)
D_IN = sum(SPLIT_SIZES)

kernel_name = 'hybrid_diffusion_parallel_heads_step'

F32 = jnp.float32


def rms_norm(x, g):
    xf = x.astype(F32)
    y = xf * lax.rsqrt(jnp.mean(xf * xf, axis=-1, keepdims=True) + EPS)
    return (y * g.astype(F32)).astype(x.dtype)


def axial_rope_tables(n_tokens, head_dim):
    pos = jnp.arange(n_tokens)
    row = (pos // GRID_W).astype(F32)
    col = (pos % GRID_W).astype(F32)
    n_freq = head_dim // 4
    inv = ROPE_BASE ** (-jnp.arange(n_freq, dtype=F32) / n_freq)
    ang = jnp.concatenate([row[:, None] * inv, col[:, None] * inv], axis=-1)
    return jnp.cos(ang), jnp.sin(ang)


def apply_rope(x, cos, sin):
    shape = (cos.shape[0],) + (1,) * (x.ndim - 3) + (cos.shape[1],)
    cs, sn = cos.reshape(shape), sin.reshape(shape)
    x1, x2 = jnp.split(x.astype(F32), 2, axis=-1)
    return jnp.concatenate([x1 * cs - x2 * sn, x1 * sn + x2 * cs], axis=-1).astype(x.dtype)


def split_projection(proj):
    points, acc = [], 0
    for s in SPLIT_SIZES[:-1]:
        acc += s
        points.append(acc)
    return jnp.split(proj, points, axis=-1)


def sink_softmax_values(s, vals, sink):
    sk = sink.astype(F32)[None, :, :, None, None]
    m = jnp.maximum(jnp.max(s, axis=-1, keepdims=True), sk)
    p = jnp.exp(s - m)
    denom = jnp.sum(p, axis=-1, keepdims=True) + jnp.exp(sk - m)
    return jnp.einsum('bkgqn,bnkd->bqkgd', p / denom, vals.astype(F32))


def gqa_context(q, k, v, sink):
    bsz, n = q.shape[:2]
    grp = ATT_HEADS // ATT_KV_HEADS
    qb = q.reshape(bsz, n // BLOCK, BLOCK, ATT_KV_HEADS, grp, ATT_HEAD_DIM).swapaxes(0, 1)
    sk = sink.reshape(ATT_KV_HEADS, grp)
    scale = ATT_HEAD_DIM ** -0.5

    def block(qblk):
        s = jnp.einsum('bqkgd,bnkd->bkgqn', qblk, k).astype(F32) * scale
        return sink_softmax_values(s, v, sk)

    o = lax.map(block, qb)
    return o.swapaxes(0, 1).reshape(bsz, n, ATT_HEADS * ATT_HEAD_DIM)


def gqa_latent(q, k, v, ctx_k, ctx_v, sink):
    bsz, n = q.shape[:2]
    grp = ATT_HEADS // ATT_KV_HEADS
    nb = n // BLOCK
    qb = q.reshape(bsz, nb, BLOCK, ATT_KV_HEADS, grp, ATT_HEAD_DIM).swapaxes(0, 1)
    sk = sink.reshape(ATT_KV_HEADS, grp)
    scale = ATT_HEAD_DIM ** -0.5
    pad = ((0, 0), (BLOCK, BLOCK), (0, 0), (0, 0))
    kp, vp = jnp.pad(k, pad), jnp.pad(v, pad)
    offs = jnp.arange(3 * BLOCK)
    qoffs = jnp.arange(BLOCK)

    def block(args):
        i, qblk = args
        start = i * BLOCK
        kw = lax.dynamic_slice_in_dim(kp, start, 3 * BLOCK, axis=1)
        vw = lax.dynamic_slice_in_dim(vp, start, 3 * BLOCK, axis=1)
        kpos = start - BLOCK + offs
        qpos = start + qoffs
        valid = ((jnp.abs(qpos[:, None] - kpos[None, :]) <= WINDOW)
                 & (kpos >= 0)[None, :] & (kpos < n)[None, :])
        s_win = jnp.einsum('bqkgd,bnkd->bkgqn', qblk, kw).astype(F32) * scale
        s_win = jnp.where(valid, s_win, NEG_INF)
        s_ctx = jnp.einsum('bqkgd,bnkd->bkgqn', qblk, ctx_k).astype(F32) * scale
        s = jnp.concatenate([s_win, s_ctx], axis=-1)
        vals = jnp.concatenate([vw, ctx_v.astype(vw.dtype)], axis=1)
        return sink_softmax_values(s, vals, sk)

    o = lax.map(block, (jnp.arange(nb), qb))
    return o.swapaxes(0, 1).reshape(bsz, n, ATT_HEADS * ATT_HEAD_DIM)


def diff_attention(q, keys, vals, lam, subln, lam_init):
    bsz, n = q.shape[:2]
    qb = q.reshape(bsz, n // BLOCK, BLOCK, 2, DIF_HEADS, DIF_QK_DIM).swapaxes(0, 1)
    scale = DIF_QK_DIM ** -0.5
    vf = vals.astype(F32)

    def block(qblk):
        s = jnp.einsum('bqmhd,bnmhd->bmhqn', qblk, keys).astype(F32) * scale
        p = jax.nn.softmax(s, axis=-1)
        a = p[:, 0] - lam * p[:, 1]
        return jnp.einsum('bhqn,bnhd->bqhd', a, vf)

    o = lax.map(block, qb).swapaxes(0, 1).reshape(bsz, n, DIF_HEADS, DIF_V_DIM)
    o = rms_norm(o, subln) * (1.0 - lam_init)
    return o.reshape(bsz, n, DIF_HEADS * DIF_V_DIM)


def hyena_filters(n, w1, b1, w2, b2, w3, freq):
    t = jnp.linspace(0.0, 1.0, n, dtype=F32)[:, None]
    w = (2.0 * math.pi / n) * jnp.arange(n, dtype=F32)[:, None]
    f = jnp.linspace(1e-4, FILT_BANDS - 1, FILT_BANDS, dtype=F32)[None, :]
    feats = jnp.concatenate([t, jnp.cos(f * w), -jnp.sin(f * w)], axis=-1)
    fr = freq.astype(F32)
    h = jnp.sin(fr * (feats @ w1.astype(F32) + b1.astype(F32)))
    h = jnp.sin(fr * (h @ w2.astype(F32) + b2.astype(F32)))
    h = (h @ w3.astype(F32)).reshape(n, 2, HY_CH)
    deltas = jnp.abs(jnp.linspace(HY_MIN_DECAY, HY_MAX_DECAY, HY_CH, dtype=F32))
    h = h * jnp.exp(-t * deltas)[:, None, :]
    h = h / (jnp.sum(jnp.abs(h), axis=(0, 1), keepdims=True) + EPS)
    return h[:, 0], h[:, 1]


def bidir_long_conv(z, hf, hb, skip):
    n = z.shape[1]
    kern = jnp.concatenate([hf, jnp.zeros((1, HY_CH), F32), hb[:0:-1]], axis=0)
    zf = z.astype(F32)
    y = jnp.fft.irfft(jnp.fft.rfft(zf, n=2 * n, axis=1) * jnp.fft.rfft(kern, axis=0)[None],
                      n=2 * n, axis=1)[:, :n]
    return y + zf * skip.astype(F32)


def hyena_mixer(u, conv_w, conv_b, w1, b1, w2, b2, w3, freq, skip):
    n = u.shape[1]
    up = jnp.pad(u, ((0, 0), (1, 1), (0, 0)))
    uc = up[:, :-2] * conv_w[0] + up[:, 1:-1] * conv_w[1] + up[:, 2:] * conv_w[2] + conv_b
    x0, x1, v = jnp.split(uc, 3, axis=-1)
    hf, hb = hyena_filters(n, w1, b1, w2, b2, w3, freq)
    return x0.astype(F32) * bidir_long_conv(x1 * v, hf, hb, skip)


def fnet_mixer(u, w, b):
    bsz, n, _ = u.shape
    ug = u.astype(F32).reshape(bsz, n, FN_GROUPS, FN_GROUP_CH)
    f = jnp.fft.fft2(ug, axes=(1, 3), norm='ortho').real
    return f.reshape(bsz, n, GROUP_W) @ w.astype(F32) + b.astype(F32)


def layer_entry(x, cond, w_ada_l, b_ada_l, g_pre_l, w_in_l):
    mod = jax.nn.silu(cond) @ w_ada_l + b_ada_l
    shift, scale, gate = jnp.split(mod[:, None, :], 3, axis=-1)
    h = rms_norm(x, g_pre_l) * (1.0 + scale) + shift
    return split_projection(h @ w_in_l), gate


def layer_exit(x, outs, gates, gate, w_out_l, g_post_l):
    mixed = jnp.concatenate([o.astype(x.dtype) * jax.nn.silu(g) for o, g in zip(outs, gates)], axis=-1)
    return x + gate * rms_norm(mixed @ w_out_l, g_post_l)


def setup_inputs(seed: int = 0) -> dict:
    key = jax.random.key(seed)
    ks = jax.random.split(key, 28)

    def nrm(k, shape, s):
        return s * jax.random.normal(k, shape, F32)

    return {
        'x_prompt': nrm(ks[0], (BATCH, SEQ, D_MODEL), 1.0),
        'x_sample': nrm(ks[1], (DEC_BATCH, DEC_SEQ, D_MODEL), 1.0),
        'cache_attn_k': nrm(ks[2], (DEC_BATCH, DEPTH, PAST_LEN, ATT_KV_HEADS, ATT_HEAD_DIM), 1.0),
        'cache_attn_v': nrm(ks[3], (DEC_BATCH, DEPTH, PAST_LEN, ATT_KV_HEADS, ATT_HEAD_DIM), 1.0),
        'cache_diff_k': nrm(ks[4], (DEC_BATCH, DEPTH, PAST_LEN, 2, DIF_HEADS, DIF_QK_DIM), 1.0),
        'cache_diff_v': nrm(ks[5], (DEC_BATCH, DEPTH, PAST_LEN, DIF_HEADS, DIF_V_DIM), 1.0),
        'c': nrm(ks[6], (DEC_BATCH, D_MODEL), 1.0),
        'c_ctx': nrm(ks[7], (D_MODEL,), 1.0),
        'w_ada': nrm(ks[8], (DEPTH, D_MODEL, 3 * D_MODEL), D_MODEL ** -0.5),
        'b_ada': nrm(ks[9], (DEPTH, 3 * D_MODEL), 0.01),
        'norm_pre': 1.0 + nrm(ks[10], (DEPTH, D_MODEL), 0.05),
        'norm_post': 1.0 + nrm(ks[11], (DEPTH, D_MODEL), 0.05),
        'w_in': nrm(ks[12], (DEPTH, D_MODEL, D_IN), D_MODEL ** -0.5),
        'w_out': nrm(ks[13], (DEPTH, D_MIX, D_MODEL), D_MIX ** -0.5),
        'attn_sink': nrm(ks[14], (DEPTH, ATT_HEADS), 0.5),
        'diff_lambda': nrm(ks[15], (DEPTH, 4, DIF_QK_DIM), 0.1),
        'diff_subln': 1.0 + nrm(ks[16], (DEPTH, DIF_V_DIM), 0.05),
        'hy_conv_w': nrm(ks[17], (DEPTH, 3, HY_STREAMS * HY_CH), 3.0 ** -0.5),
        'hy_conv_b': nrm(ks[18], (DEPTH, HY_STREAMS * HY_CH), 0.01),
        'hy_filt_w1': nrm(ks[19], (DEPTH, FILT_EMB, FILT_HIDDEN), FILT_EMB ** -0.5),
        'hy_filt_b1': nrm(ks[20], (DEPTH, FILT_HIDDEN), 0.1),
        'hy_filt_w2': nrm(ks[21], (DEPTH, FILT_HIDDEN, FILT_HIDDEN), FILT_HIDDEN ** -0.5),
        'hy_filt_b2': nrm(ks[22], (DEPTH, FILT_HIDDEN), 0.1),
        'hy_filt_w3': nrm(ks[23], (DEPTH, FILT_HIDDEN, 2 * HY_CH), FILT_HIDDEN ** -0.5),
        'hy_filt_freq': 1.0 + nrm(ks[24], (DEPTH, FILT_HIDDEN), 0.05),
        'hy_skip': nrm(ks[25], (DEPTH, HY_CH), 0.5),
        'fn_w': nrm(ks[26], (DEPTH, GROUP_W, GROUP_W), GROUP_W ** -0.5),
        'fn_b': nrm(ks[27], (DEPTH, GROUP_W), 0.01),
    }


def reference(x_prompt, x_sample, cache_attn_k, cache_attn_v, cache_diff_k, cache_diff_v, c, c_ctx,
              w_ada, b_ada, norm_pre, norm_post, w_in, w_out, attn_sink, diff_lambda, diff_subln,
              hy_conv_w, hy_conv_b, hy_filt_w1, hy_filt_b1, hy_filt_w2, hy_filt_b2, hy_filt_w3,
              hy_filt_freq, hy_skip, fn_w, fn_b):
    bp, lp, _ = x_prompt.shape
    bs, ls, _ = x_sample.shape
    cos_a, sin_a = axial_rope_tables(ls, ATT_HEAD_DIM)
    cos_d, sin_d = axial_rope_tables(ls, DIF_QK_DIM)
    xp, xs = x_prompt, x_sample
    st_ak, st_av, st_dk, st_dv = [], [], [], []
    for l in range(DEPTH):
        lam_init = 0.8 - 0.6 * math.exp(-0.3 * l)
        lam_par = diff_lambda[l].astype(F32)
        lam = jnp.exp(jnp.sum(lam_par[0] * lam_par[1])) - jnp.exp(jnp.sum(lam_par[2] * lam_par[3])) + lam_init
        hy_args = (hy_conv_w[l], hy_conv_b[l], hy_filt_w1[l], hy_filt_b1[l], hy_filt_w2[l], hy_filt_b2[l],
                   hy_filt_w3[l], hy_filt_freq[l], hy_skip[l])
        entry = (w_ada[l], b_ada[l], norm_pre[l], w_in[l])

        (aq, ak, av, ag, dq, dk, dv, dg, hu, hg, fu, fg), gate = layer_entry(xp, c_ctx[None, :], *entry)
        aq = aq.reshape(bp, lp, ATT_HEADS, ATT_HEAD_DIM)
        ak = ak.reshape(bp, lp, ATT_KV_HEADS, ATT_HEAD_DIM)
        av = av.reshape(bp, lp, ATT_KV_HEADS, ATT_HEAD_DIM)
        dq = dq.reshape(bp, lp, 2, DIF_HEADS, DIF_QK_DIM)
        dk = dk.reshape(bp, lp, 2, DIF_HEADS, DIF_QK_DIM)
        dv = dv.reshape(bp, lp, DIF_HEADS, DIF_V_DIM)
        outs = (gqa_context(aq, ak, av, attn_sink[l]),
                diff_attention(dq, dk, dv, lam, diff_subln[l], lam_init),
                hyena_mixer(hu, *hy_args),
                fnet_mixer(fu, fn_w[l], fn_b[l]))
        st_ak.append(ak)
        st_av.append(av)
        st_dk.append(dk)
        st_dv.append(dv)
        xp = layer_exit(xp, outs, (ag, dg, hg, fg), gate, w_out[l], norm_post[l])

        (aq, ak, av, ag, dq, dk, dv, dg, hu, hg, fu, fg), gate = layer_entry(xs, c, *entry)
        aq = apply_rope(aq.reshape(bs, ls, ATT_HEADS, ATT_HEAD_DIM), cos_a, sin_a)
        ak = apply_rope(ak.reshape(bs, ls, ATT_KV_HEADS, ATT_HEAD_DIM), cos_a, sin_a)
        av = av.reshape(bs, ls, ATT_KV_HEADS, ATT_HEAD_DIM)
        dq = apply_rope(dq.reshape(bs, ls, 2, DIF_HEADS, DIF_QK_DIM), cos_d, sin_d)
        dk = apply_rope(dk.reshape(bs, ls, 2, DIF_HEADS, DIF_QK_DIM), cos_d, sin_d)
        dv = dv.reshape(bs, ls, DIF_HEADS, DIF_V_DIM)
        keys = jnp.concatenate([dk, cache_diff_k[:, l].astype(dk.dtype)], axis=1)
        vals = jnp.concatenate([dv, cache_diff_v[:, l].astype(dv.dtype)], axis=1)
        outs = (gqa_latent(aq, ak, av, cache_attn_k[:, l], cache_attn_v[:, l], attn_sink[l]),
                diff_attention(dq, keys, vals, lam, diff_subln[l], lam_init),
                hyena_mixer(hu, *hy_args),
                fnet_mixer(fu, fn_w[l], fn_b[l]))
        xs = layer_exit(xs, outs, (ag, dg, hg, fg), gate, w_out[l], norm_post[l])

    return (xp, xs, jnp.stack(st_ak, axis=1), jnp.stack(st_av, axis=1), jnp.stack(st_dk, axis=1), jnp.stack(st_dv, axis=1))
```

```cpp
#include <hip/hip_runtime.h>
#include <hip/hip_cooperative_groups.h>
#include <cstdio>
#include <cstdint>
namespace cg = cooperative_groups;

typedef unsigned short bf16_t;
typedef short bf16x8 __attribute__((ext_vector_type(8)));
typedef short s16x4 __attribute__((ext_vector_type(4)));
typedef float f32x4 __attribute__((ext_vector_type(4)));
typedef float f32x16 __attribute__((ext_vector_type(16)));
typedef unsigned u32x4 __attribute__((ext_vector_type(4)));
#define DI __device__ __forceinline__

#ifndef MULTI_LAUNCH
#define MULTI_LAUNCH 0
#endif

constexpr int D = 1024, MCTX = 8192, MLAT = 16384, MTOT = 24576, NIN = 3584, DIN = 3328;
constexpr size_t MiB = 1u << 20;
constexpr size_t OFF_H = 0, OFF_QA = 48 * MiB, OFF_KA = 60 * MiB, OFF_VAT = 66 * MiB, OFF_G = 72 * MiB, OFF_QD = 108 * MiB,
                 OFF_KD = 120 * MiB, OFF_VDT = 132 * MiB, OFF_HUT = 144 * MiB, OFF_HGT = 180 * MiB, OFF_PT = 192 * MiB,
                 OFF_O = 48 * MiB, OFF_WIT = 216 * MiB, OFF_WOT = 230 * MiB, OFF_WFU = 234 * MiB, OFF_M1T = 235 * MiB,
                 OFF_FILT = 236 * MiB, OFF_KCA = 245 * MiB, OFF_VCAT = 246 * MiB, OFF_KCD = 247 * MiB, OFF_VCDT = 249 * MiB,
                 OFF_COSA = 251 * MiB, OFF_SINA = 251 * MiB + 512 * 1024, OFF_COSD = 252 * MiB, OFF_SIND = 252 * MiB + 256 * 1024,
                 OFF_MOD = 252 * MiB + 512 * 1024, OFF_BAR = 253 * MiB;
constexpr int FILT_L = 512 * 256 + 512 * 4096;
constexpr int OUT_AK = MTOT * D, OUT_AV = OUT_AK + 2097152, OUT_DK = OUT_AV + 2097152, OUT_DV = OUT_DK + 4194304;

struct Params { const float* in[28]; float* out; char* ws; };

DI float bf2f(bf16_t b) { return __uint_as_float(((unsigned)b) << 16); }
typedef float f32x2 __attribute__((ext_vector_type(2)));
typedef __bf16 hbf2 __attribute__((ext_vector_type(2)));
DI unsigned pk2(float a, float b) { f32x2 v = {a, b}; hbf2 r = __builtin_convertvector(v, hbf2); return __builtin_bit_cast(unsigned, r); }
DI bf16_t f2bf(float x) { return (bf16_t)(pk2(x, 0.f) & 0xffffu); }
DI float silu(float x) { return x / (1.f + __expf(-x)); }
DI f32x16 mfma32(bf16x8 a, bf16x8 b, f32x16 c) { return __builtin_amdgcn_mfma_f32_32x32x16_bf16(a, b, c, 0, 0, 0); }
DI f32x4 mfma16(bf16x8 a, bf16x8 b, f32x4 c) { return __builtin_amdgcn_mfma_f32_16x16x32_bf16(a, b, c, 0, 0, 0); }
DI int crow(int reg, int h) { return (reg & 3) + 8 * (reg >> 2) + 4 * h; }
DI int otid() { int t = threadIdx.x; asm volatile("" : "+v"(t)); return t; }
DI float wave_sum(float v) { for (int o = 32; o > 0; o >>= 1) v += __shfl_xor(v, o); return v; }

__shared__ __attribute__((aligned(16))) char smem[81920];

struct LdPlain { const bf16_t* p; size_t ld;
  DI bf16x8 operator()(int row, int k) const { return *(const bf16x8*)(p + (size_t)row * ld + k); } };

template <bool SWAP, bool AROW = false, class LA, class LB>
DI void gemm_core(f32x4 (&acc)[4][4], const LA& la, const LB& lb, int nk, bf16x8 (&ra0)[4], bf16x8 (&rb0)[4], bool preloaded) {
  bf16_t* sA = (bf16_t*)smem; bf16_t* sB = (bf16_t*)(smem + 16384);
  const int tid = otid(), lane = tid & 63, wid = tid >> 6, wr = wid >> 1, wc = wid & 1, fr = lane & 15, fq = lane >> 4;
#pragma unroll
  for (int i = 0; i < 4; ++i)
#pragma unroll
    for (int j = 0; j < 4; ++j) acc[i][j] = f32x4{0.f, 0.f, 0.f, 0.f};
  auto gl = [&](int kt, bf16x8 (&ra)[4], bf16x8 (&rb)[4]) {
#pragma unroll
    for (int i = 0; i < 4; ++i) { int id = tid + i * 256; int row = id >> 3, kc = (id & 7) * 8; rb[i] = lb(row, kt * 64 + kc);
      if (AROW) { row = tid >> 1; kc = ((tid & 1) * 4 + i) * 8; } ra[i] = la(row, kt * 64 + kc); } };
  auto lw = [&](bf16x8 (&ra)[4], bf16x8 (&rb)[4]) {
#pragma unroll
    for (int i = 0; i < 4; ++i) { int id = tid + i * 256; int row = id >> 3, kc = (id & 7) * 8;
      *(bf16x8*)(sB + row * 64 + (kc ^ (((row >> 1) & 7) * 8))) = rb[i]; if (AROW) { row = tid >> 1; kc = ((tid & 1) * 4 + i) * 8; } *(bf16x8*)(sA + row * 64 + (kc ^ (((row >> 1) & 7) * 8))) = ra[i]; } };
  auto comp = [&]() {
#pragma unroll
    for (int ks = 0; ks < 2; ++ks) {
      bf16x8 a[4], b[4];
#pragma unroll
      for (int mi = 0; mi < 4; ++mi) a[mi] = *(const bf16x8*)(sA + (wr * 64 + mi * 16 + fr) * 64 + (((ks * 4 + fq) ^ ((fr >> 1) & 7)) * 8));
#pragma unroll
      for (int ni = 0; ni < 4; ++ni) b[ni] = *(const bf16x8*)(sB + (wc * 64 + ni * 16 + fr) * 64 + (((ks * 4 + fq) ^ ((fr >> 1) & 7)) * 8));
#pragma unroll
      for (int mi = 0; mi < 4; ++mi)
#pragma unroll
        for (int ni = 0; ni < 4; ++ni) acc[mi][ni] = SWAP ? mfma16(b[ni], a[mi], acc[mi][ni]) : mfma16(a[mi], b[ni], acc[mi][ni]);
    } };
  if (!preloaded) gl(0, ra0, rb0);
#pragma unroll 1
  for (int kt = 0; kt < nk; ++kt) {
    __syncthreads();
    lw(ra0, rb0);
    __syncthreads();
    if (kt + 1 < nk) gl(kt + 1, ra0, rb0);
    __builtin_amdgcn_sched_barrier(0);
    comp();
  }
  __syncthreads();
}

template <bool SWAP, class LA, class LB>
DI void gemm_core(f32x4 (&acc)[4][4], const LA& la, const LB& lb, int nk) { bf16x8 ra0[4], rb0[4]; gemm_core<SWAP>(acc, la, lb, nk, ra0, rb0, false); }
DI void gemm_prefetch(const bf16_t* A, size_t lda, const bf16_t* B, size_t ldb, bf16x8 (&ra)[4], bf16x8 (&rb)[4]) {
  const int tid = otid();
#pragma unroll
  for (int i = 0; i < 4; ++i) { int id = tid + i * 256; int row = id >> 3, kc = (id & 7) * 8; ra[i] = *(const bf16x8*)(A + (size_t)row * lda + kc); rb[i] = *(const bf16x8*)(B + (size_t)row * ldb + kc); }
  __builtin_amdgcn_sched_barrier(0);
}

template <bool SWAP, class LA, class LB>
DI void gemm_core_db(f32x4 (&acc)[4][4], const LA& la, const LB& lb, int nk, bf16x8 (&ra0)[4], bf16x8 (&rb0)[4], bool preloaded) {
  const int tid = otid(), lane = tid & 63, wid = tid >> 6, wr = wid >> 1, wc = wid & 1, fr = lane & 15, fq = lane >> 4;
#pragma unroll
  for (int i = 0; i < 4; ++i)
#pragma unroll
    for (int j = 0; j < 4; ++j) acc[i][j] = f32x4{0.f, 0.f, 0.f, 0.f};
  auto gl = [&](int kt, bf16x8 (&ra)[4], bf16x8 (&rb)[4]) {
#pragma unroll
    for (int i = 0; i < 4; ++i) { int id = tid + i * 256; int row = id >> 3, kc = (id & 7) * 8; ra[i] = la(row, kt * 64 + kc); rb[i] = lb(row, kt * 64 + kc); } };
  auto lw = [&](int st, bf16x8 (&ra)[4], bf16x8 (&rb)[4]) {
    bf16_t* sA = (bf16_t*)(smem + st * 36864); bf16_t* sB = (bf16_t*)(smem + st * 36864 + 16384);
#pragma unroll
    for (int i = 0; i < 4; ++i) { int id = tid + i * 256; int row = id >> 3, kc = (id & 7) * 8;
      *(bf16x8*)(sA + row * 64 + (kc ^ (((row >> 1) & 7) * 8))) = ra[i]; *(bf16x8*)(sB + row * 64 + (kc ^ (((row >> 1) & 7) * 8))) = rb[i]; } };
  auto comp = [&](int st) {
    const bf16_t* sA = (const bf16_t*)(smem + st * 36864); const bf16_t* sB = (const bf16_t*)(smem + st * 36864 + 16384);
#pragma unroll
    for (int ks = 0; ks < 2; ++ks) {
      bf16x8 a[4], b[4];
#pragma unroll
      for (int mi = 0; mi < 4; ++mi) a[mi] = *(const bf16x8*)(sA + (wr * 64 + mi * 16 + fr) * 64 + (((ks * 4 + fq) ^ ((fr >> 1) & 7)) * 8));
#pragma unroll
      for (int ni = 0; ni < 4; ++ni) b[ni] = *(const bf16x8*)(sB + (wc * 64 + ni * 16 + fr) * 64 + (((ks * 4 + fq) ^ ((fr >> 1) & 7)) * 8));
#pragma unroll
      for (int mi = 0; mi < 4; ++mi)
#pragma unroll
        for (int ni = 0; ni < 4; ++ni) acc[mi][ni] = SWAP ? mfma16(b[ni], a[mi], acc[mi][ni]) : mfma16(a[mi], b[ni], acc[mi][ni]);
    } };
  if (!preloaded) gl(0, ra0, rb0);
  __syncthreads();
  lw(0, ra0, rb0);
  if (nk > 1) gl(1, ra0, rb0);
  __syncthreads();
#pragma unroll 1
  for (int kt = 0; kt < nk; kt += 2) {
    if (kt + 1 < nk) lw(1, ra0, rb0);
    if (kt + 2 < nk) gl(kt + 2, ra0, rb0);
    __builtin_amdgcn_sched_barrier(0);
    comp(0);
    __syncthreads();
    if (kt + 1 < nk) {
      if (kt + 2 < nk) lw(0, ra0, rb0);
      if (kt + 3 < nk) gl(kt + 3, ra0, rb0);
      __builtin_amdgcn_sched_barrier(0);
      comp(1);
      __syncthreads();
    }
  }
}

#define LDS_AS __attribute__((address_space(3)))
template <bool SWAP>
DI void gemm_core_dma(f32x4 (&acc)[4][4], const bf16_t* A, int lda, const bf16_t* B, int ldb, int nk) {
  const int tid = otid(), lane = tid & 63, wid = tid >> 6, wr = wid >> 1, wc = wid & 1, fr = lane & 15, fq = lane >> 4;
#pragma unroll
  for (int i = 0; i < 4; ++i)
#pragma unroll
    for (int j = 0; j < 4; ++j) acc[i][j] = f32x4{0.f, 0.f, 0.f, 0.f};
  unsigned offa[4], offb[4];
#pragma unroll
  for (int i = 0; i < 4; ++i) { const int L = (wid * 4 + i) * 64 + lane; const int row = L >> 3, pos = L & 7; const int c = pos ^ ((row >> 1) & 7);
    offa[i] = (unsigned)(row * lda + c * 8); offb[i] = (unsigned)(row * ldb + c * 8); }
  auto dma = [&](int st, int kt) {
#pragma unroll
    for (int i = 0; i < 4; ++i) { const int L0 = (wid * 4 + i) * 64;
      __builtin_amdgcn_global_load_lds((const unsigned*)(A + offa[i] + kt * 64), (LDS_AS unsigned*)(smem + st * 36864 + L0 * 16), 16, 0, 0);
      __builtin_amdgcn_global_load_lds((const unsigned*)(B + offb[i] + kt * 64), (LDS_AS unsigned*)(smem + st * 36864 + 16384 + L0 * 16), 16, 0, 0); } };
  auto comp = [&](int st) {
    const bf16_t* sA = (const bf16_t*)(smem + st * 36864); const bf16_t* sB = (const bf16_t*)(smem + st * 36864 + 16384);
#pragma unroll
    for (int ks = 0; ks < 2; ++ks) {
      bf16x8 a[4], b[4];
#pragma unroll
      for (int mi = 0; mi < 4; ++mi) a[mi] = *(const bf16x8*)(sA + (wr * 64 + mi * 16 + fr) * 64 + (((ks * 4 + fq) ^ ((fr >> 1) & 7)) * 8));
#pragma unroll
      for (int ni = 0; ni < 4; ++ni) b[ni] = *(const bf16x8*)(sB + (wc * 64 + ni * 16 + fr) * 64 + (((ks * 4 + fq) ^ ((fr >> 1) & 7)) * 8));
#pragma unroll
      for (int mi = 0; mi < 4; ++mi)
#pragma unroll
        for (int ni = 0; ni < 4; ++ni) acc[mi][ni] = SWAP ? mfma16(b[ni], a[mi], acc[mi][ni]) : mfma16(a[mi], b[ni], acc[mi][ni]);
    } };
  __syncthreads();
  dma(0, 0);
  asm volatile("s_waitcnt vmcnt(0)" ::: "memory");
  __syncthreads();
#pragma unroll 1
  for (int kt = 0; kt < nk; kt += 2) {
    dma(1, kt + 1);
    comp(0);
    asm volatile("s_waitcnt vmcnt(0)" ::: "memory");
    __syncthreads();
    if (kt + 2 < nk) dma(0, kt + 2);
    comp(1);
    asm volatile("s_waitcnt vmcnt(0)" ::: "memory");
    __syncthreads();
  }
}

DI void gemm_core_outproj(f32x4 (&acc)[4][4], const bf16_t* A, int lda, const bf16_t* B, int ldb, const bf16_t* AT, int tok0) {
  constexpr int nk = 16;
  const int tid = otid(), lane = tid & 63, wid = tid >> 6, wr = wid >> 1, wc = wid & 1, fr = lane & 15, fq = lane >> 4;
#pragma unroll
  for (int i = 0; i < 4; ++i)
#pragma unroll
    for (int j = 0; j < 4; ++j) acc[i][j] = f32x4{0.f, 0.f, 0.f, 0.f};
  unsigned offa[4], offb[4];
#pragma unroll
  for (int i = 0; i < 4; ++i) { const int L = (wid * 4 + i) * 64 + lane; const int row = L >> 3, pos = L & 7; const int c = pos ^ ((row >> 1) & 7);
    offa[i] = (unsigned)(row * lda + c * 8); offb[i] = (unsigned)(row * ldb + c * 8); }
  bf16x8 tr[4];
  auto fill = [&](int st, int kt) {
    const bool T = (kt >= 8 && kt < 12);
#pragma unroll
    for (int i = 0; i < 4; ++i) { const int L0 = (wid * 4 + i) * 64;
      if (!T) __builtin_amdgcn_global_load_lds((const unsigned*)(A + offa[i] + kt * 64), (LDS_AS unsigned*)(smem + st * 36864 + L0 * 16), 16, 0, 0);
      __builtin_amdgcn_global_load_lds((const unsigned*)(B + offb[i] + kt * 64), (LDS_AS unsigned*)(smem + st * 36864 + 16384 + L0 * 16), 16, 0, 0); }
    if (T) {
#pragma unroll
      for (int i = 0; i < 4; ++i) { const int id = tid + i * 256; const int ch = id >> 4, tc = (id & 15) * 8;
        tr[i] = *(const bf16x8*)(AT + (size_t)((kt - 8) * 64 + ch) * MTOT + tok0 + tc); }
    } };
  auto fillT = [&](int st, int kt) {
    if (kt >= 8 && kt < 12) {
      char* sA = smem + st * 36864;
#pragma unroll
      for (int i = 0; i < 4; ++i) { const int id = tid + i * 256; const int ch = id >> 4, tc = (id & 15) * 8;
#pragma unroll
        for (int e = 0; e < 8; ++e) { const int row = tc + e; *(bf16_t*)(sA + row * 128 + (((ch >> 3) ^ ((row >> 1) & 7)) * 16) + (ch & 7) * 2) = (bf16_t)tr[i][e]; } }
    } };
  auto comp = [&](int st) {
    const bf16_t* sA = (const bf16_t*)(smem + st * 36864); const bf16_t* sB = (const bf16_t*)(smem + st * 36864 + 16384);
#pragma unroll
    for (int ks = 0; ks < 2; ++ks) {
      bf16x8 a[4], b[4];
#pragma unroll
      for (int mi = 0; mi < 4; ++mi) a[mi] = *(const bf16x8*)(sA + (wr * 64 + mi * 16 + fr) * 64 + (((ks * 4 + fq) ^ ((fr >> 1) & 7)) * 8));
#pragma unroll
      for (int ni = 0; ni < 4; ++ni) b[ni] = *(const bf16x8*)(sB + (wc * 64 + ni * 16 + fr) * 64 + (((ks * 4 + fq) ^ ((fr >> 1) & 7)) * 8));
#pragma unroll
      for (int mi = 0; mi < 4; ++mi)
#pragma unroll
        for (int ni = 0; ni < 4; ++ni) acc[mi][ni] = mfma16(b[ni], a[mi], acc[mi][ni]);
    } };
  __syncthreads();
  fill(0, 0);
  asm volatile("s_waitcnt vmcnt(0)" ::: "memory");
  __syncthreads();
#pragma unroll 1
  for (int kt = 0; kt < nk; kt += 2) {
    fill(1, kt + 1);
    comp(0);
    fillT(1, kt + 1);
    asm volatile("s_waitcnt vmcnt(0)" ::: "memory");
    __syncthreads();
    if (kt + 2 < nk) fill(0, kt + 2);
    comp(1);
    if (kt + 2 < nk) fillT(0, kt + 2);
    asm volatile("s_waitcnt vmcnt(0)" ::: "memory");
    __syncthreads();
  }
}

template <class F>
DI void stage_T(f32x4 (&acc)[4][4], F f) {
  bf16_t* sC = (bf16_t*)smem;
  const int tid = otid(), lane = tid & 63, wid = tid >> 6, wr = wid >> 1, wc = wid & 1, fr = lane & 15, fq = lane >> 4;
#pragma unroll
  for (int mi = 0; mi < 4; ++mi)
#pragma unroll
    for (int ni = 0; ni < 4; ++ni) { const int row = wr * 64 + mi * 16 + fq * 4, col = wc * 64 + ni * 16 + fr;
      uint2 v; v.x = pk2(f(col, acc[mi][ni][0]), f(col, acc[mi][ni][1])); v.y = pk2(f(col, acc[mi][ni][2]), f(col, acc[mi][ni][3]));
      *(uint2*)(sC + col * 136 + row) = v; }
  __syncthreads();
}
template <class F>
DI void stage_R(f32x4 (&acc)[4][4], F f) {
  bf16_t* sC = (bf16_t*)smem;
  const int tid = otid(), lane = tid & 63, wid = tid >> 6, wr = wid >> 1, wc = wid & 1, fr = lane & 15, fq = lane >> 4;
#pragma unroll
  for (int mi = 0; mi < 4; ++mi)
#pragma unroll
    for (int ni = 0; ni < 4; ++ni) { const int row = wr * 64 + mi * 16 + fr, col = wc * 64 + ni * 16 + fq * 4;
      uint2 v; v.x = pk2(f(col, acc[mi][ni][0]), f(col + 1, acc[mi][ni][1])); v.y = pk2(f(col + 2, acc[mi][ni][2]), f(col + 3, acc[mi][ni][3]));
      *(uint2*)(sC + row * 136 + col) = v; }
  __syncthreads();
}
DI void store_img(bf16_t* dst, size_t ld) {
  const bf16_t* sC = (const bf16_t*)smem; const int tid = otid();
#pragma unroll
  for (int i = 0; i < 8; ++i) { const int id = tid + i * 256; const int r = id >> 4, c = (id & 15) * 8;
    *(bf16x8*)(dst + (size_t)r * ld + c) = *(const bf16x8*)(sC + r * 136 + c); }
}
template <int HD>
DI void store_rope(bf16_t* dst, size_t ld, int pos0, const float* cs, const float* sn) {
  const bf16_t* sC = (const bf16_t*)smem; const int tid = otid();
  constexpr int HALF = HD / 2, CPH = HALF / 8;
#pragma unroll
  for (int k = 0; k < 4; ++k) { const int id = tid + k * 256; const int r = id >> 3, q = id & 7; const int head = q / CPH, i8 = q % CPH; const int pos = pos0 + r;
    const int cbase = head * HD + i8 * 8;
    const bf16x8 x1 = *(const bf16x8*)(sC + r * 136 + cbase), x2 = *(const bf16x8*)(sC + r * 136 + cbase + HALF);
    const float4* cp = (const float4*)(cs + pos * HALF + i8 * 8); const float4* sp = (const float4*)(sn + pos * HALF + i8 * 8);
    const float4 c0 = cp[0], c1 = cp[1], s0 = sp[0], s1 = sp[1];
    const float cc[8] = {c0.x, c0.y, c0.z, c0.w, c1.x, c1.y, c1.z, c1.w}, ss[8] = {s0.x, s0.y, s0.z, s0.w, s1.x, s1.y, s1.z, s1.w};
    u32x4 o1, o2;
#pragma unroll
    for (int e = 0; e < 4; ++e) {
      const float a0 = bf2f((bf16_t)x1[2 * e]), b0 = bf2f((bf16_t)x2[2 * e]), a1 = bf2f((bf16_t)x1[2 * e + 1]), b1 = bf2f((bf16_t)x2[2 * e + 1]);
      o1[e] = pk2(a0 * cc[2 * e] - b0 * ss[2 * e], a1 * cc[2 * e + 1] - b1 * ss[2 * e + 1]);
      o2[e] = pk2(a0 * ss[2 * e] + b0 * cc[2 * e], a1 * ss[2 * e + 1] + b1 * cc[2 * e + 1]); }
    *(u32x4*)(dst + (size_t)r * ld + cbase) = o1; *(u32x4*)(dst + (size_t)r * ld + cbase + HALF) = o2; }
}
template <bool SWAP>
DI void store_acc_f32(f32x4 (&acc)[4][4], float* dst, size_t ld) {
  const int tid = otid(), lane = tid & 63, wid = tid >> 6, wr = wid >> 1, wc = wid & 1, fr = lane & 15, fq = lane >> 4;
#pragma unroll
  for (int mi = 0; mi < 4; ++mi)
#pragma unroll
    for (int ni = 0; ni < 4; ++ni) {
      if (SWAP) { const int row = wr * 64 + mi * 16 + fr, col = wc * 64 + ni * 16 + fq * 4; *(f32x4*)(dst + (size_t)row * ld + col) = acc[mi][ni]; }
      else {
#pragma unroll
        for (int j = 0; j < 4; ++j) { const int row = wr * 64 + mi * 16 + fq * 4 + j, col = wc * 64 + ni * 16 + fr; dst[(size_t)row * ld + col] = acc[mi][ni][j]; } }
    }
}

DI void task_mod(const Params& p, int t) {
  int l = t / 96, j0 = (t % 96) * 32; float* sc = (float*)smem;
  __syncthreads();
  for (int i = otid(); i < 5 * 1024; i += 256) { int r = i >> 10, k = i & 1023; float v = r == 0 ? p.in[7][k] : p.in[6][(r - 1) * 1024 + k]; sc[i] = silu(v); }
  __syncthreads();
  int col = otid() & 31, ks = otid() >> 5; const float* w = p.in[8] + (size_t)l * 1024 * 3072 + j0 + col;
  float a[5] = {0, 0, 0, 0, 0};
#pragma unroll 16
  for (int k = ks * 128; k < ks * 128 + 128; ++k) { float wv = w[(size_t)k * 3072];
#pragma unroll
    for (int r = 0; r < 5; ++r) a[r] += sc[r * 1024 + k] * wv; }
  float* red = sc + 5120;
#pragma unroll
  for (int r = 0; r < 5; ++r) red[(ks * 5 + r) * 32 + col] = a[r];
  __syncthreads();
  for (int i = otid(); i < 160; i += 256) { int r = i >> 5, c = i & 31; float s = 0.f;
#pragma unroll
    for (int q = 0; q < 8; ++q) s += red[(q * 5 + r) * 32 + c];
    ((float*)(p.ws + OFF_MOD))[(l * 5 + r) * 3072 + j0 + c] = s + p.in[9][l * 3072 + j0 + c]; }
}
DI void task_transpose(const float* src, size_t ld, bf16_t* dst, size_t ldd) {
  bf16_t* tl = (bf16_t*)smem;
  const int tid = otid();
  __syncthreads();
#pragma unroll 4
  for (int i0 = 0; i0 < 64; i0 += 16) {
    float v[16];
#pragma unroll
    for (int u = 0; u < 16; ++u) v[u] = src[(size_t)(i0 + u) * ld + tid];
#pragma unroll
    for (int u = 0; u < 16; ++u) tl[tid * 72 + i0 + u] = f2bf(v[u]);
  }
  __syncthreads();
#pragma unroll
  for (int i = 0; i < 8; ++i) { const int id = tid + i * 256; const int n = id >> 3, kc = (id & 7) * 8; *(bf16x8*)(dst + (size_t)n * ldd + kc) = *(const bf16x8*)(tl + n * 72 + kc); }
}
DI void task_win(const Params& p, int t) {
  const int l = t / 208, r = t % 208, kt = r / 13, nt = r % 13, k0 = kt * 64, n0 = nt * 256;
  const float* src = p.in[12] + (size_t)l * 1024 * DIN + (size_t)k0 * DIN + n0;
  if (nt == 11) {
    bf16_t* dst = (bf16_t*)(p.ws + OFF_WFU) + (size_t)l * 1024 * 256 + (size_t)k0 * 256; const int tid = otid();
#pragma unroll 16
    for (int rr = 0; rr < 64; ++rr) dst[(size_t)rr * 256 + tid] = f2bf(src[(size_t)rr * DIN + tid]);
    return;
  }
  const int nd = n0 < 2816 ? n0 : n0 + 256;
  task_transpose(src, DIN, (bf16_t*)(p.ws + OFF_WIT) + (size_t)l * NIN * 1024 + (size_t)nd * 1024 + k0, 1024);
}
DI void task_wout(const Params& p, int t) {
  const int l = t / 64, r = t % 64, kt = r / 4, nt = r % 4;
  task_transpose(p.in[13] + (size_t)l * 1024 * 1024 + (size_t)kt * 64 * 1024 + nt * 256, 1024,
                 (bf16_t*)(p.ws + OFF_WOT) + (size_t)l * 1024 * 1024 + (size_t)nt * 256 * 1024 + kt * 64, 1024);
}
DI void task_m1(const Params& p, int t) {
  int l = t >> 8, cp = t & 255, g = cp >> 6, c = cp & 63; float* cs = (float*)smem; float* sn = cs + 64;
  __syncthreads();
  if (otid() < 64) { int m = otid(); int ph = (m * c) & 63; cs[m] = cospif(ph / 32.f); sn[m] = sinpif(ph / 32.f); }
  __syncthreads();
  const float* fw = p.in[26] + (size_t)l * 65536 + (size_t)(g * 64) * 256; int j = otid();
  float ac = 0, as = 0;
  for (int m = 0; m < 64; ++m) { float w = fw[m * 256 + j]; ac += cs[m] * w; as += sn[m] * w; }
  bf16_t* m1 = (bf16_t*)(p.ws + OFF_M1T) + (size_t)l * 512 * 256;
  m1[(size_t)j * 256 + cp] = f2bf(ac); m1[(size_t)(256 + j) * 256 + cp] = f2bf(as);
}
DI void task_filter(const Params& p, int t2) {
  const int t = t2 >> 1, half0 = t2 & 1;
  int l = t / 68, r = t % 68, set = r >= 4, pb = set ? r - 4 : r, n = set ? 4096 : 256, p0 = pb * 64;
  float* feats = (float*)smem; float* h1 = feats + 64 * 33; float* h2 = h1 + 64 * 64;
  bf16_t* stg = (bf16_t*)(smem + 41216);
  const int tid = otid(); const int pp0 = tid & 63, grp = tid >> 6;
  __syncthreads();
  { const int pos = p0 + pp0; float tt = (float)pos / (float)(n - 1); float w = (6.283185307179586f / (float)n) * (float)pos;
    for (int i = grp; i < 33; i += 4) { float v;
      if (i == 0) v = tt; else { int j = (i - 1) & 15; float f = 1e-4f + (float)j * ((15.f - 1e-4f) / 15.f); v = i <= 16 ? cosf(f * w) : -sinf(f * w); }
      feats[pp0 * 33 + i] = v; } }
  __syncthreads();
  const float* w1 = p.in[19] + l * 33 * 64; const float* b1 = p.in[20] + l * 64; const float* w2 = p.in[21] + l * 4096; const float* b2 = p.in[22] + l * 64;
  const float* w3 = p.in[23] + (size_t)l * 64 * 512; const float* fr = p.in[24] + l * 64;
  const int j = tid & 63, pg = tid >> 6;
  { float wc[33];
#pragma unroll
    for (int i = 0; i < 33; ++i) wc[i] = w1[i * 64 + j];
    const float bj = b1[j], fj = fr[j];
    for (int pp = pg * 16; pp < pg * 16 + 16; ++pp) { float a = bj;
#pragma unroll
      for (int i = 0; i < 33; ++i) a += feats[pp * 33 + i] * wc[i];
      h1[pp * 64 + j] = sinf(fj * a); } }
  __syncthreads();
  { float wc[64];
#pragma unroll
    for (int i = 0; i < 64; ++i) wc[i] = w2[i * 64 + j];
    const float bj = b2[j], fj = fr[j];
    for (int pp = pg * 16; pp < pg * 16 + 16; ++pp) { float a = bj;
#pragma unroll
      for (int i = 0; i < 64; ++i) a += h1[pp * 64 + i] * wc[i];
      h2[pp * 64 + j] = sinf(fj * a); } }
  __syncthreads();
  bf16_t* F = (bf16_t*)(p.ws + OFF_FILT) + (size_t)l * FILT_L + (set ? 512 * 256 : 0);
  for (int half = half0; half <= half0; ++half) {
    const int o = half * 256 + tid; float wc[64];
#pragma unroll
    for (int k = 0; k < 64; ++k) wc[k] = w3[k * 512 + o];
    const int c = o & 255; const float delta = fabsf(-3.0701134573253945f + (-15.350567286626973f + 3.0701134573253945f) * ((float)c / 255.f));
    for (int pp = 0; pp < 64; ++pp) { float a = 0.f;
#pragma unroll
      for (int k = 0; k < 64; ++k) a += h2[pp * 64 + k] * wc[k];
      float tt = (float)(p0 + pp) / (float)(n - 1);
      stg[tid * 72 + pp] = f2bf(a * expf(-tt * delta)); }
    __syncthreads();
#pragma unroll
    for (int i = 0; i < 8; ++i) { int id = tid + i * 256; int row = id >> 3, pc = (id & 7) * 8;
      *(bf16x8*)(F + (size_t)(half * 256 + row) * n + p0 + pc) = *(const bf16x8*)(stg + row * 72 + pc); }
    __syncthreads();
  }
}
DI void task_elem(const Params& p, int t, int nt) {
  const int stride = nt * 256; const int g0 = t * 256 + otid();
  bf16_t* kca = (bf16_t*)(p.ws + OFF_KCA); bf16_t* vcat = (bf16_t*)(p.ws + OFF_VCAT); bf16_t* kcd = (bf16_t*)(p.ws + OFF_KCD); bf16_t* vcdt = (bf16_t*)(p.ws + OFF_VCDT);
  for (int i = g0; i < 4 * 2 * 512 * 128; i += stride) {
    kca[i] = f2bf(p.in[2][i]);
    int n = i & 511, ch = (i >> 9) & 127, bl = i >> 16; vcat[i] = f2bf(p.in[3][((size_t)bl * 512 + n) * 128 + ch]);
  }
  for (int i = g0; i < 4 * 2 * 512 * 256; i += stride) {
    kcd[i] = f2bf(p.in[4][i]);
    int n = i & 511, ch = (i >> 9) & 255, bl = i >> 17; vcdt[i] = f2bf(p.in[5][((size_t)bl * 512 + n) * 256 + ch]);
  }
  float* cosA = (float*)(p.ws + OFF_COSA); float* sinA = (float*)(p.ws + OFF_SINA); float* cosD = (float*)(p.ws + OFF_COSD); float* sinD = (float*)(p.ws + OFF_SIND);
  for (int i = g0; i < 4096 * 32; i += stride) { int pos = i >> 5, k = i & 31; float base = k < 16 ? (float)(pos >> 6) : (float)(pos & 63); int f = k & 15;
    float inv = powf(10000.f, -(float)f / 16.f); float ang = base * inv; cosA[i] = cosf(ang); sinA[i] = sinf(ang); }
  for (int i = g0; i < 4096 * 16; i += stride) { int pos = i >> 4, k = i & 15; float base = k < 8 ? (float)(pos >> 6) : (float)(pos & 63); int f = k & 7;
    float inv = powf(10000.f, -(float)f / 8.f); float ang = base * inv; cosD[i] = cosf(ang); sinD[i] = sinf(ang); }
}

DI int modrow(int row) { return row < MCTX ? 0 : 1 + ((row - MCTX) >> 12); }
DI const float* xrow_in(const Params& p, int row) { return row < MCTX ? p.in[0] + (size_t)row * D : p.in[1] + (size_t)(row - MCTX) * D; }
DI void task_prep(const Params& p, int row) {
  const int lane = otid() & 63; const float* x = xrow_in(p, row); const float* mod = (const float*)(p.ws + OFF_MOD) + (size_t)(0 * 5 + modrow(row)) * 3072;
  float v[16]; float ss = 0;
#pragma unroll
  for (int j = 0; j < 2; ++j) { const float4* s = (const float4*)(x + lane * 8 + 512 * j); float4 a = s[0], b = s[1];
    v[j * 8 + 0] = a.x; v[j * 8 + 1] = a.y; v[j * 8 + 2] = a.z; v[j * 8 + 3] = a.w; v[j * 8 + 4] = b.x; v[j * 8 + 5] = b.y; v[j * 8 + 6] = b.z; v[j * 8 + 7] = b.w; }
#pragma unroll
  for (int i = 0; i < 16; ++i) ss += v[i] * v[i];
  ss = wave_sum(ss); float rn = rsqrtf(ss * (1.f / 1024.f) + 1e-6f);
  bf16_t* H = (bf16_t*)(p.ws + OFF_H) + (size_t)row * D;
#pragma unroll
  for (int j = 0; j < 2; ++j) { bf16x8 o;
#pragma unroll
    for (int e = 0; e < 8; ++e) { int c = lane * 8 + 512 * j + e; o[e] = (short)f2bf(v[j * 8 + e] * rn * p.in[10][c] * (1.f + mod[1024 + c]) + mod[c]); }
    *(bf16x8*)(H + lane * 8 + 512 * j) = o; }
}
DI void task_final(const Params& p, int l, int row0) {
  const int lane = otid() & 63; const int mr = modrow(row0);
  const float* mod = (const float*)(p.ws + OFF_MOD) + (size_t)(l * 5 + mr) * 3072;
  float ov[2][16], xv[2][16];
#pragma unroll
  for (int rr = 0; rr < 2; ++rr) { const int row = row0 + rr;
    const float* x = l == 0 ? xrow_in(p, row) : p.out + (size_t)row * D; const bf16_t* o = (const bf16_t*)(p.ws + OFF_O) + (size_t)row * D;
#pragma unroll
    for (int j = 0; j < 2; ++j) { bf16x8 t = *(const bf16x8*)(o + lane * 8 + 512 * j);
#pragma unroll
      for (int e = 0; e < 8; ++e) ov[rr][j * 8 + e] = bf2f((bf16_t)t[e]);
      const float4* s = (const float4*)(x + lane * 8 + 512 * j); float4 a = s[0], b = s[1];
      xv[rr][j * 8 + 0] = a.x; xv[rr][j * 8 + 1] = a.y; xv[rr][j * 8 + 2] = a.z; xv[rr][j * 8 + 3] = a.w; xv[rr][j * 8 + 4] = b.x; xv[rr][j * 8 + 5] = b.y; xv[rr][j * 8 + 6] = b.z; xv[rr][j * 8 + 7] = b.w; } }
  float gp[16];
#pragma unroll
  for (int j = 0; j < 2; ++j)
#pragma unroll
    for (int e = 0; e < 8; ++e) { const int c = lane * 8 + 512 * j + e; gp[j * 8 + e] = mod[2048 + c] * p.in[11][l * 1024 + c]; }
  const float* mod1 = (const float*)(p.ws + OFF_MOD) + (size_t)(5 + mr) * 3072;
#pragma unroll
  for (int rr = 0; rr < 2; ++rr) { const int row = row0 + rr;
    float ss = 0;
#pragma unroll
    for (int i = 0; i < 16; ++i) ss += ov[rr][i] * ov[rr][i];
    ss = wave_sum(ss); const float rn = rsqrtf(ss * (1.f / 1024.f) + 1e-6f); float s2 = 0;
#pragma unroll
    for (int i = 0; i < 16; ++i) { const float y = xv[rr][i] + gp[i] * (ov[rr][i] * rn); xv[rr][i] = y; s2 += y * y; }
    float* dst = p.out + (size_t)row * D;
#pragma unroll
    for (int j = 0; j < 2; ++j) { float4* d = (float4*)(dst + lane * 8 + 512 * j);
      d[0] = make_float4(xv[rr][j * 8 + 0], xv[rr][j * 8 + 1], xv[rr][j * 8 + 2], xv[rr][j * 8 + 3]); d[1] = make_float4(xv[rr][j * 8 + 4], xv[rr][j * 8 + 5], xv[rr][j * 8 + 6], xv[rr][j * 8 + 7]); }
    if (l == 0) {
      s2 = wave_sum(s2); const float r1 = rsqrtf(s2 * (1.f / 1024.f) + 1e-6f);
      bf16_t* H = (bf16_t*)(p.ws + OFF_H) + (size_t)row * D;
#pragma unroll
      for (int j = 0; j < 2; ++j) { u32x4 ob;
#pragma unroll
        for (int e = 0; e < 4; ++e) { const int c = lane * 8 + 512 * j + 2 * e;
          ob[e] = pk2(xv[rr][j * 8 + 2 * e] * r1 * p.in[10][1024 + c] * (1.f + mod1[1024 + c]) + mod1[c], xv[rr][j * 8 + 2 * e + 1] * r1 * p.in[10][1024 + c + 1] * (1.f + mod1[1024 + c + 1]) + mod1[c + 1]); }
        *(u32x4*)(H + lane * 8 + 512 * j) = ob; }
    }
  }
}

DI void task_fold(const Params& p, int t) {
  int l = t >> 5, mt = (t >> 2) & 7, ct = t & 3; f32x4 acc[4][4];
  LdPlain la{(const bf16_t*)(p.ws + OFF_WFU) + (size_t)l * 1024 * 256 + (size_t)mt * 128 * 256, 256};
  LdPlain lb{(const bf16_t*)(p.ws + OFF_M1T) + (size_t)l * 512 * 256 + (size_t)ct * 128 * 256, 256};
  gemm_core<false>(acc, la, lb, 4);
  stage_T(acc, [](int, float v) { return v; });
  store_img((bf16_t*)(p.ws + OFF_WIT) + (size_t)l * NIN * 1024 + (size_t)(2816 + ct * 128) * 1024 + mt * 128, 1024);
}
DI void task_inproj(const Params& p, int l, int t, int tnext, bf16x8 (&pra)[4], bf16x8 (&prb)[4]) {
  int mt = t / 28, ct = t % 28; int row0 = mt * 128; bool lat = mt >= 64; f32x4 acc[4][4];
  LdPlain la{(const bf16_t*)(p.ws + OFF_H) + (size_t)row0 * D, D};
  LdPlain lb{(const bf16_t*)(p.ws + OFF_WIT) + (size_t)l * NIN * 1024 + (size_t)ct * 128 * 1024, 1024};
  const bool ttile = (ct == 3 || ct == 10 || ct == 11 || (ct >= 14 && ct < 26));
  const int pos0 = lat ? ((row0 - MCTX) & 4095) : 0;
  char* ws = p.ws;
  const int b = row0 >> 8, t0 = row0 & 255; const size_t r128 = ((size_t)(b * 2 + l) * 256 + t0);
  const bf16_t* nA = nullptr; const bf16_t* nB = nullptr;
  if (tnext >= 0) { nA = (const bf16_t*)(p.ws + OFF_H) + (size_t)(tnext / 28) * 128 * D; nB = (const bf16_t*)(p.ws + OFF_WIT) + (size_t)l * NIN * 1024 + (size_t)(tnext % 28) * 128 * 1024; }
  if (ttile) {
    gemm_core_dma<false>(acc, la.p, D, lb.p, 1024, 16);
    if (!lat) {
      if (ct == 3) store_acc_f32<false>(acc, p.out + OUT_AV + r128 * 128, 128);
      else if (ct == 10 || ct == 11) store_acc_f32<false>(acc, p.out + OUT_DV + r128 * 256 + (ct - 10) * 128, 256);
    }
    if (ct == 20 || ct == 21) stage_T(acc, [](int, float v) { return silu(v); }); else stage_T(acc, [](int, float v) { return v; });
    if (ct == 3) store_img((bf16_t*)(ws + OFF_VAT) + row0, MTOT);
    else if (ct < 12) store_img((bf16_t*)(ws + OFF_VDT) + (size_t)(ct - 10) * 128 * MTOT + row0, MTOT);
    else if (ct < 20) store_img((bf16_t*)(ws + OFF_HUT) + (size_t)(ct - 14) * 128 * MTOT + row0, MTOT);
    else if (ct < 22) store_img((bf16_t*)(ws + OFF_HGT) + (size_t)(ct - 20) * 128 * MTOT + row0, MTOT);
    else store_img((bf16_t*)(ws + OFF_PT) + (size_t)(ct - 22) * 128 * MTOT + row0, MTOT);
  } else {
    gemm_core_dma<true>(acc, la.p, D, lb.p, 1024, 16);
    if (!lat) {
      if (ct == 2) store_acc_f32<true>(acc, p.out + OUT_AK + r128 * 128, 128);
      else if (ct == 8 || ct == 9) store_acc_f32<true>(acc, p.out + OUT_DK + r128 * 256 + (ct - 8) * 128, 256);
    }
    const bool gate = (ct == 4 || ct == 5 || ct == 12 || ct == 13 || ct >= 26);
    if (gate) stage_R(acc, [](int, float v) { return silu(v); }); else stage_R(acc, [](int, float v) { return v; });
    const float* cosA = (const float*)(ws + OFF_COSA); const float* sinA = (const float*)(ws + OFF_SINA); const float* cosD = (const float*)(ws + OFF_COSD); const float* sinD = (const float*)(ws + OFF_SIND);
    if (ct < 2) { bf16_t* d = (bf16_t*)(ws + OFF_QA) + (size_t)row0 * 256 + ct * 128; if (lat) store_rope<64>(d, 256, pos0, cosA, sinA); else store_img(d, 256); }
    else if (ct == 2) { bf16_t* d = (bf16_t*)(ws + OFF_KA) + (size_t)row0 * 128; if (lat) store_rope<64>(d, 128, pos0, cosA, sinA); else store_img(d, 128); }
    else if (ct < 6) store_img((bf16_t*)(ws + OFF_G) + (size_t)row0 * 768 + (ct - 4) * 128, 768);
    else if (ct < 8) { bf16_t* d = (bf16_t*)(ws + OFF_QD) + (size_t)row0 * 256 + (ct - 6) * 128; if (lat) store_rope<32>(d, 256, pos0, cosD, sinD); else store_img(d, 256); }
    else if (ct < 10) { bf16_t* d = (bf16_t*)(ws + OFF_KD) + (size_t)row0 * 256 + (ct - 8) * 128; if (lat) store_rope<32>(d, 256, pos0, cosD, sinD); else store_img(d, 256); }
    else if (ct < 14) store_img((bf16_t*)(ws + OFF_G) + (size_t)row0 * 768 + 256 + (ct - 12) * 128, 768);
    else store_img((bf16_t*)(ws + OFF_G) + (size_t)row0 * 768 + 512 + (ct - 26) * 128, 768);
  }
}
DI void task_outproj(const Params& p, int l, int t, int tnext, bf16x8 (&pra)[4], bf16x8 (&prb)[4]) {
  int mt = t >> 3, ct = t & 7; f32x4 acc[4][4];
  LdPlain la{(const bf16_t*)(p.ws + OFF_H) + (size_t)mt * 128 * D, D};
  LdPlain lb{(const bf16_t*)(p.ws + OFF_WOT) + (size_t)l * 1024 * 1024 + (size_t)ct * 128 * 1024, 1024};
  gemm_core_outproj(acc, la.p, D, lb.p, 1024, (const bf16_t*)(p.ws + OFF_HUT), mt * 128);
  stage_R(acc, [](int, float v) { return v; });
  store_img((bf16_t*)(p.ws + OFF_O) + (size_t)mt * 128 * D + ct * 128, D);
}
struct LdDft { const float* tab; int n, k; float ce[8], se[8];
  DI bf16x8 operator()(int, int kk) const { const int part = kk >= n; const int t = kk - (part ? n : 0);
    const int idx = (k * t) & (n - 1); const float ca = tab[idx], sa = tab[(idx - (n >> 2)) & (n - 1)];
    u32x4 o;
    if (!part) {
#pragma unroll
      for (int e = 0; e < 4; ++e) o[e] = pk2(ca * ce[2 * e] - sa * se[2 * e], ca * ce[2 * e + 1] - sa * se[2 * e + 1]);
    } else {
#pragma unroll
      for (int e = 0; e < 4; ++e) o[e] = pk2(-(sa * ce[2 * e] + ca * se[2 * e]), -(sa * ce[2 * e + 1] + ca * se[2 * e + 1]));
    }
    return __builtin_bit_cast(bf16x8, o); } };
struct LdPT { const bf16_t* base; int n;
  DI bf16x8 operator()(int row, int kk) const { int part = kk >= n; int t = kk - (part ? n : 0); return *(const bf16x8*)(base + (size_t)(part * 256 + row) * MTOT + t); } };
DI float dft_cos(const float* tab, int n, int idx) { idx &= (n - 1); return tab[min(idx, n - idx)]; }
DI void fnet_core(f32x4 (&acc)[4][4], const float* tab, int n, int krow, const float (&ce)[8], const float (&se)[8], const bf16_t* Bbase) {
  const int nk = 2 * n / 64;
  const int tid = otid(), lane = tid & 63, wid = tid >> 6, wr = wid >> 1, wc = wid & 1, fr = lane & 15, fq = lane >> 4;
#pragma unroll
  for (int i = 0; i < 4; ++i)
#pragma unroll
    for (int j = 0; j < 4; ++j) acc[i][j] = f32x4{0.f, 0.f, 0.f, 0.f};
  unsigned offb[4];
#pragma unroll
  for (int i = 0; i < 4; ++i) { const int L = (wid * 4 + i) * 64 + lane; const int row = L >> 3, pos = L & 7; const int c = pos ^ ((row >> 1) & 7); offb[i] = (unsigned)(row * MTOT + c * 8); }
  const int arow = tid >> 1;
  auto dmaB = [&](int st, int kt) { const int kk0 = kt * 64; const int part = kk0 >= n; const unsigned koff = (unsigned)(part * 256 * MTOT + kk0 - (part ? n : 0));
#pragma unroll
    for (int i = 0; i < 4; ++i)
      __builtin_amdgcn_global_load_lds((const unsigned*)(Bbase + offb[i] + koff), (LDS_AS unsigned*)(smem + st * 32768 + 16384 + (wid * 4 + i) * 1024), 16, 0, 0); };
  auto genA = [&](int st, int kt) { char* sA = smem + st * 32768; const int part = (kt * 64) >= n;
#pragma unroll
    for (int i = 0; i < 4; ++i) { const int chunk = (tid & 1) * 4 + i; const int t = kt * 64 + chunk * 8 - (part ? n : 0);
      const int idx = krow * t; const float ca = dft_cos(tab, n, idx), sa = dft_cos(tab, n, idx - (n >> 2));
      u32x4 o;
      if (!part) {
#pragma unroll
        for (int e = 0; e < 4; ++e) o[e] = pk2(ca * ce[2 * e] - sa * se[2 * e], ca * ce[2 * e + 1] - sa * se[2 * e + 1]);
      } else {
#pragma unroll
        for (int e = 0; e < 4; ++e) o[e] = pk2(-(sa * ce[2 * e] + ca * se[2 * e]), -(sa * ce[2 * e + 1] + ca * se[2 * e + 1]));
      }
      *(u32x4*)(sA + arow * 128 + ((chunk ^ ((arow >> 1) & 7)) * 16)) = o; } };
  auto comp = [&](int st) {
    const bf16_t* sA = (const bf16_t*)(smem + st * 32768); const bf16_t* sB = (const bf16_t*)(smem + st * 32768 + 16384);
#pragma unroll
    for (int ks = 0; ks < 2; ++ks) {
      bf16x8 a[4], b[4];
#pragma unroll
      for (int mi = 0; mi < 4; ++mi) a[mi] = *(const bf16x8*)(sA + (wr * 64 + mi * 16 + fr) * 64 + (((ks * 4 + fq) ^ ((fr >> 1) & 7)) * 8));
#pragma unroll
      for (int ni = 0; ni < 4; ++ni) b[ni] = *(const bf16x8*)(sB + (wc * 64 + ni * 16 + fr) * 64 + (((ks * 4 + fq) ^ ((fr >> 1) & 7)) * 8));
#pragma unroll
      for (int mi = 0; mi < 4; ++mi)
#pragma unroll
        for (int ni = 0; ni < 4; ++ni) acc[mi][ni] = mfma16(b[ni], a[mi], acc[mi][ni]);
    } };
  __syncthreads();
  dmaB(0, 0); genA(0, 0);
  asm volatile("s_waitcnt vmcnt(0)" ::: "memory");
  __syncthreads();
#pragma unroll 1
  for (int kt = 0; kt < nk; kt += 2) {
    dmaB(1, kt + 1); genA(1, kt + 1);
    comp(0);
    asm volatile("s_waitcnt vmcnt(0)" ::: "memory");
    __syncthreads();
    if (kt + 2 < nk) { dmaB(0, kt + 2); genA(0, kt + 2); }
    comp(1);
    asm volatile("s_waitcnt vmcnt(0)" ::: "memory");
    __syncthreads();
  }
}
DI void task_fnet(const Params& p, int l, int set, int t) {
  int n = set ? 4096 : 256; int ct = t & 1, rt = set ? (t >> 1) & 31 : (t >> 1) & 1, b = set ? t >> 6 : t >> 2;
  int tokbase = set ? MCTX + b * 4096 : b * 256;
  float* tab = (float*)(smem + 65536);
  __syncthreads();
  for (int i = otid(); i <= n / 2; i += 256) tab[i] = cospif(2.f * (float)i / (float)n);
  __syncthreads();
  f32x4 acc[4][4];
  const int krow = rt * 128 + (otid() >> 1); float ce[8], se[8];
#pragma unroll
  for (int e = 0; e < 8; ++e) { ce[e] = dft_cos(tab, n, krow * e); se[e] = dft_cos(tab, n, krow * e - (n >> 2)); }
  fnet_core(acc, tab, n, krow, ce, se, (const bf16_t*)(p.ws + OFF_PT) + (size_t)ct * 128 * MTOT + tokbase);
  float scale = rsqrtf(64.f * (float)n); const float* fb = p.in[27] + l * 256 + ct * 128;
  stage_R(acc, [=](int col, float v) { return v * scale + fb[col]; });
  const bf16_t* sC = (const bf16_t*)smem; const int tid = otid();
  const bf16_t* g = (const bf16_t*)(p.ws + OFF_G) + (size_t)(tokbase + rt * 128) * 768 + 512 + ct * 128;
  bf16_t* dst = (bf16_t*)(p.ws + OFF_H) + (size_t)(tokbase + rt * 128) * D + 768 + ct * 128;
#pragma unroll
  for (int i = 0; i < 8; ++i) { const int id = tid + i * 256; const int r = id >> 4, c = (id & 15) * 8;
    const bf16x8 v = *(const bf16x8*)(sC + r * 136 + c), gg = *(const bf16x8*)(g + (size_t)r * 768 + c); u32x4 o;
#pragma unroll
    for (int e = 0; e < 4; ++e) o[e] = pk2(bf2f((bf16_t)v[2 * e]) * bf2f((bf16_t)gg[2 * e]), bf2f((bf16_t)v[2 * e + 1]) * bf2f((bf16_t)gg[2 * e + 1]));
    *(u32x4*)(dst + (size_t)r * D + c) = o; }
}

DI bf16x8 vt_frag(const bf16_t* Vt, size_t ldv, int dt, int s2, int r, int h) {
  const bf16_t* vp = Vt + (size_t)(dt * 32 + r) * ldv + 16 * s2 + 4 * h;
  s16x4 lo = *(const s16x4*)vp, hi = *(const s16x4*)(vp + 8);
  return __builtin_shufflevector(lo, hi, 0, 1, 2, 3, 4, 5, 6, 7);
}
template <bool DIFF>
DI void task_attn(const Params& p, int l, int set, int b, int head, int qb) {
  constexpr int NM = DIFF ? 2 : 1, KS = DIFF ? 2 : 4, LDK = DIFF ? 256 : 128, VCH = DIFF ? 256 : 128;
  const int tid = otid(), lane = tid & 63, w = tid >> 6, r = lane & 31, h = lane >> 5;
  const int n = set ? 4096 : 256, tokbase = set ? MCTX + b * 4096 : b * 256, q0 = qb * 128 + w * 32;
  const int hoffq = DIFF ? head * 32 : head * 64, hoffk = DIFF ? head * 32 : (head >> 1) * 64, vch = DIFF ? head * 64 : (head >> 1) * 64;
  const bf16_t* Q = (const bf16_t*)(p.ws + (DIFF ? OFF_QD : OFF_QA));
  const bf16_t* K1 = (const bf16_t*)(p.ws + (DIFF ? OFF_KD : OFF_KA)); const bf16_t* V1 = (const bf16_t*)(p.ws + (DIFF ? OFF_VDT : OFF_VAT));
  const bf16_t* K2 = (const bf16_t*)(p.ws + (DIFF ? OFF_KCD : OFF_KCA)) + (size_t)(b * 2 + l) * 512 * LDK + hoffk;
  const bf16_t* V2 = (const bf16_t*)(p.ws + (DIFF ? OFF_VCDT : OFF_VCAT)) + ((size_t)(b * 2 + l) * VCH + vch) * 512;
  int tile0 = 0, nt1 = n >> 7;
  if (!DIFF && set) { tile0 = max(0, qb - 1); nt1 = min(31, qb + 1) - tile0 + 1; }
  const int ntt = nt1 + (set ? 4 : 0);
  bf16_t* sK = (bf16_t*)smem; bf16_t* sV = (bf16_t*)(smem + 18432);
  bf16x8 qf[NM][KS];
#pragma unroll
  for (int mm = 0; mm < NM; ++mm)
#pragma unroll
    for (int ks = 0; ks < KS; ++ks) qf[mm][ks] = *(const bf16x8*)(Q + (size_t)(tokbase + q0 + r) * 256 + mm * 128 + hoffq + ks * 16 + 8 * h);
  const float c = (DIFF ? 0.17677669529663687f : 0.125f) * 1.4426950408889634f;
  float m[NM], ls[NM]; f32x16 O[NM][2];
#pragma unroll
  for (int mm = 0; mm < NM; ++mm) {
    if (DIFF) { m[mm] = -1e30f; ls[mm] = 0.f; } else { m[mm] = p.in[14][l * 4 + head] * 1.4426950408889634f; ls[mm] = h == 0 ? 1.f : 0.f; }
#pragma unroll
    for (int dt = 0; dt < 2; ++dt) for (int i = 0; i < 16; ++i) O[mm][dt][i] = 0.f;
  }
  auto gload = [&](int ti, bf16x8 (&kr)[4], bf16x8 (&vr)[4]) {
    const bf16_t* kb; const bf16_t* vb; size_t ldv;
    if (ti < nt1) { const int n0 = (tile0 + ti) * 128; kb = K1 + (size_t)(tokbase + n0) * LDK + hoffk; vb = V1 + (size_t)vch * MTOT + tokbase + n0; ldv = MTOT; }
    else { const int n0 = (ti - nt1) * 128; kb = K2 + (size_t)n0 * LDK; vb = V2 + n0; ldv = 512; }
#pragma unroll
    for (int i = 0; i < 4; ++i) { const int id = tid + i * 256; const int key = id >> 3, cc = id & 7; const int coff = DIFF ? ((cc >> 2) * 128 + (cc & 3) * 8) : cc * 8;
      kr[i] = *(const bf16x8*)(kb + (size_t)key * LDK + coff);
      const int d = id >> 4, c2 = id & 15; vr[i] = *(const bf16x8*)(vb + (size_t)d * ldv + c2 * 8); }
  };
  auto compute = [&](int ti, int sub) {
    bool masked = false; int nbase = 0;
    if (!DIFF && set && ti < nt1) { nbase = (tile0 + ti) * 128 + sub * 32; if (nbase + 31 < q0 - 128 || nbase > q0 + 159) return; masked = true; }
    bf16x8 vf[2][2];
#pragma unroll
    for (int dt = 0; dt < 2; ++dt)
#pragma unroll
      for (int s2 = 0; s2 < 2; ++s2) { const bf16_t* vp = sV + (dt * 32 + r) * 132 + sub * 32 + 16 * s2 + 4 * h; s16x4 lo = *(const s16x4*)vp, hi = *(const s16x4*)(vp + 8);
        vf[dt][s2] = __builtin_shufflevector(lo, hi, 0, 1, 2, 3, 4, 5, 6, 7); }
#pragma unroll
    for (int mm = 0; mm < NM; ++mm) {
      f32x16 s;
#pragma unroll
      for (int i = 0; i < 16; ++i) s[i] = 0.f;
#pragma unroll
      for (int ks = 0; ks < KS; ++ks) { bf16x8 kf = *(const bf16x8*)(sK + (sub * 32 + r) * 72 + (DIFF ? mm * 32 : 0) + ks * 16 + 8 * h); s = mfma32(kf, qf[mm][ks], s); }
      if (masked) {
        const int dq = q0 + r - nbase - 4 * h;
#pragma unroll
        for (int i = 0; i < 16; ++i) { int dd = dq - ((i & 3) + 8 * (i >> 2)); if (dd > 128 || dd < -128) s[i] = -1e30f; }
      }
      float mx = fmaxf(fmaxf(s[0], s[1]), s[2]);
#pragma unroll
      for (int i = 3; i < 15; i += 2) mx = fmaxf(fmaxf(mx, s[i]), s[i + 1]);
      mx = fmaxf(mx, s[15]);
      {
        auto rr = __builtin_amdgcn_permlane32_swap(__float_as_uint(mx), __float_as_uint(mx), false, false);
        mx = fmaxf(__uint_as_float(rr[0]), __uint_as_float(rr[1])); }
      const float mxs = mx * c;
      if (__any(mxs - m[mm] > 8.f)) {
        const float mn2 = fmaxf(m[mm], mxs);
        const float alpha = __builtin_amdgcn_exp2f(m[mm] - mn2); ls[mm] *= alpha;
#pragma unroll
        for (int dt = 0; dt < 2; ++dt)
#pragma unroll
          for (int i = 0; i < 16; ++i) O[mm][dt][i] *= alpha;
        m[mm] = mn2;
      }
      const float mn = m[mm]; float sum = 0.f;
#pragma unroll
      for (int i = 0; i < 16; ++i) { float pe = __builtin_amdgcn_exp2f(__builtin_fmaf(s[i], c, -mn)); s[i] = pe; sum += pe; }
      ls[mm] += sum;
      bf16x8 pf[2];
#pragma unroll
      for (int s2 = 0; s2 < 2; ++s2) { u32x4 u;
#pragma unroll
        for (int j = 0; j < 4; ++j) u[j] = pk2(s[8 * s2 + 2 * j], s[8 * s2 + 2 * j + 1]);
        pf[s2] = __builtin_bit_cast(bf16x8, u); }
#pragma unroll
      for (int dt = 0; dt < 2; ++dt)
#pragma unroll
        for (int s2 = 0; s2 < 2; ++s2) O[mm][dt] = mfma32(vf[dt][s2], pf[s2], O[mm][dt]);
    }
  };
  {
    bf16x8 kr[4], vr[4];
    gload(0, kr, vr);
    for (int ti = 0; ti < ntt; ++ti) {
      __syncthreads();
#pragma unroll
      for (int i = 0; i < 4; ++i) { const int id = tid + i * 256; *(bf16x8*)(sK + (id >> 3) * 72 + (id & 7) * 8) = kr[i]; { bf16_t* vd = sV + (id >> 4) * 132 + (id & 15) * 8; const s16x4 vlo = __builtin_shufflevector(vr[i], vr[i], 0, 1, 2, 3), vhi = __builtin_shufflevector(vr[i], vr[i], 4, 5, 6, 7); *(s16x4*)vd = vlo; *(s16x4*)(vd + 4) = vhi; } }
      __syncthreads();
      if (ti + 1 < ntt) gload(ti + 1, kr, vr);
      __builtin_amdgcn_sched_barrier(0);
#pragma unroll 2
      for (int sub = 0; sub < 4; ++sub) compute(ti, sub);
    }
    __syncthreads();
  }
  const int tok = tokbase + q0 + r;
  if (!DIFF) {
    float lt = ls[0] + __shfl_xor(ls[0], 32); float inv = 1.f / lt;
    const bf16_t* G = (const bf16_t*)(p.ws + OFF_G) + (size_t)tok * 768 + head * 64; bf16_t* dst = (bf16_t*)(p.ws + OFF_H) + (size_t)tok * D + head * 64;
#pragma unroll
    for (int dt = 0; dt < 2; ++dt)
#pragma unroll
      for (int g4 = 0; g4 < 4; ++g4) { int d = dt * 32 + 8 * g4 + 4 * h; s16x4 gg = *(const s16x4*)(G + d), o;
#pragma unroll
        for (int e = 0; e < 4; ++e) o[e] = (short)f2bf(O[0][dt][4 * g4 + e] * inv * bf2f((bf16_t)gg[e]));
        *(s16x4*)(dst + d) = o; }
  } else {
    const float* lp = p.in[15] + l * 128; float d01 = 0, d23 = 0;
    for (int i = 0; i < 32; ++i) { d01 += lp[i] * lp[32 + i]; d23 += lp[64 + i] * lp[96 + i]; }
    const float lam_init = 0.8f - 0.6f * expf(-0.3f * (float)l); const float lam = expf(d01) - expf(d23) + lam_init;
    float l0 = ls[0] + __shfl_xor(ls[0], 32), l1 = ls[NM - 1] + __shfl_xor(ls[NM - 1], 32);
    float i0 = 1.f / l0, i1 = lam / l1, ss = 0;
#pragma unroll
    for (int dt = 0; dt < 2; ++dt)
#pragma unroll
      for (int i = 0; i < 16; ++i) { float o = O[0][dt][i] * i0 - O[NM - 1][dt][i] * i1; O[0][dt][i] = o; ss += o * o; }
    ss += __shfl_xor(ss, 32); float rn = rsqrtf(ss * (1.f / 64.f) + 1e-6f) * (1.f - lam_init);
    const float* sub = p.in[16] + l * 64;
    const bf16_t* G = (const bf16_t*)(p.ws + OFF_G) + (size_t)tok * 768 + 256 + head * 64; bf16_t* dst = (bf16_t*)(p.ws + OFF_H) + (size_t)tok * D + 256 + head * 64;
#pragma unroll
    for (int dt = 0; dt < 2; ++dt)
#pragma unroll
      for (int g4 = 0; g4 < 4; ++g4) { int d = dt * 32 + 8 * g4 + 4 * h; s16x4 gg = *(const s16x4*)(G + d), o;
#pragma unroll
        for (int e = 0; e < 4; ++e) o[e] = (short)f2bf(O[0][dt][4 * g4 + e] * rn * sub[d + e] * bf2f((bf16_t)gg[e]));
        *(s16x4*)(dst + d) = o; }
  }
}

template <int SET>
DI void task_hyena(const Params& p, int l, int c) {
  constexpr int n = SET ? 4096 : 256, NB = SET ? 4 : 32, PAD = SET ? 1024 : 256, ZP = SET ? 6144 : 768, ZOFF = SET ? 16512 : 1152, ZPP = ZP * 5 / 4, NT = SET ? 4 : 2;
  const int tid = otid(), lane = tid & 63, w = tid >> 6, r = lane & 31, h = lane >> 5;
  bf16_t* kr = (bf16_t*)smem;
  bf16_t* zs = (bf16_t*)(smem + ZOFF);
  float* red = (float*)(smem + ZOFF + NB * ZPP * 2);
  const bf16_t* F = (const bf16_t*)(p.ws + OFF_FILT) + (size_t)l * FILT_L + (SET ? 512 * 256 : 0);
  const bf16_t* hf = F + (size_t)c * n; const bf16_t* hb = F + (size_t)(256 + c) * n;
  const bf16_t* HuT = (const bf16_t*)(p.ws + OFF_HUT);
  __syncthreads();
  constexpr int NC = n / 8, CH = (NC + 255) / 256;
  bf16x8 fh[CH], fb[CH]; float s = 0;
#pragma unroll
  for (int k = 0; k < CH; ++k) { const int ci = tid + k * 256;
    if (ci < NC) { fh[k] = *(const bf16x8*)(hf + ci * 8); fb[k] = *(const bf16x8*)(hb + ci * 8);
#pragma unroll
      for (int e = 0; e < 8; ++e) s += fabsf(bf2f((bf16_t)fh[k][e])) + fabsf(bf2f((bf16_t)fb[k][e])); } }
  { bf16x8 zz = {0, 0, 0, 0, 0, 0, 0, 0}; for (int i = tid; i < NB * ZPP / 8; i += 256) *(bf16x8*)(zs + i * 8) = zz; }
  s = wave_sum(s); if (lane == 0) red[w] = s;
  __syncthreads();
  const float inv = 1.f / (red[0] + red[1] + red[2] + red[3] + 1e-6f); const float skip = p.in[25][l * 256 + c];
#pragma unroll
  for (int k = 0; k < CH; ++k) { const int ci = tid + k * 256;
    if (ci < NC) {
#pragma unroll
      for (int e = 0; e < 8; ++e) { const int d = ci * 8 + e; float v = bf2f((bf16_t)fh[k][e]) * inv; if (d == 0) v += skip; kr[n + d] = f2bf(v);
        if (d > 0) kr[n - d] = f2bf(bf2f((bf16_t)fb[k][e]) * inv); } } }
  if (tid < 33) kr[tid == 32 ? 0 : 2 * n + tid] = 0;
  const float* cw = p.in[17] + l * 3 * 768; const float* cb = p.in[18] + l * 768;
  const float w10 = cw[256 + c], w11 = cw[768 + 256 + c], w12 = cw[1536 + 256 + c], b1 = cb[256 + c];
  const float w20 = cw[512 + c], w21 = cw[768 + 512 + c], w22 = cw[1536 + 512 + c], b2 = cb[512 + c];
  const float w00 = cw[c], w01 = cw[768 + c], w02 = cw[1536 + c], b0 = cb[c];
  const int tb0 = SET ? MCTX : 0;
  constexpr int CHZ = NB * NC / 256;
  const bf16_t* U1 = HuT + (size_t)(256 + c) * MTOT + tb0; const bf16_t* U2 = HuT + (size_t)(512 + c) * MTOT + tb0;
#pragma unroll
  for (int k = 0; k < CHZ; ++k) { const int ci = tid + k * 256; const int b = ci / NC, s0 = (ci - b * NC) * 8; const int off = b * n + s0;
    const bf16x8 c1 = *(const bf16x8*)(U1 + off), c2 = *(const bf16x8*)(U2 + off);
    const float p1 = s0 > 0 ? bf2f(U1[off - 1]) : 0.f, n1 = s0 + 8 < n ? bf2f(U1[off + 8]) : 0.f;
    const float p2 = s0 > 0 ? bf2f(U2[off - 1]) : 0.f, n2 = s0 + 8 < n ? bf2f(U2[off + 8]) : 0.f;
    float x1[10], x2[10]; x1[0] = p1; x2[0] = p2; x1[9] = n1; x2[9] = n2;
#pragma unroll
    for (int e = 0; e < 8; ++e) { x1[e + 1] = bf2f((bf16_t)c1[e]); x2[e + 1] = bf2f((bf16_t)c2[e]); }
    u32x4 zo;
#pragma unroll
    for (int e = 0; e < 4; ++e) {
      float za = (x1[2 * e] * w10 + x1[2 * e + 1] * w11 + x1[2 * e + 2] * w12 + b1) * (x2[2 * e] * w20 + x2[2 * e + 1] * w21 + x2[2 * e + 2] * w22 + b2);
      float zb2 = (x1[2 * e + 1] * w10 + x1[2 * e + 2] * w11 + x1[2 * e + 3] * w12 + b1) * (x2[2 * e + 1] * w20 + x2[2 * e + 2] * w21 + x2[2 * e + 3] * w22 + b2);
      zo[e] = pk2(za, zb2); }
    const int sp = PAD + s0;
    *(u32x4*)(zs + b * ZPP + sp + 8 * (sp >> 5)) = zo; }
  __syncthreads();
  f32x16 acc[NT];
#pragma unroll
  for (int j = 0; j < NT; ++j) for (int i = 0; i < 16; ++i) acc[j][i] = 0.f;
  constexpr int DMIN = SET ? -255 : -15, DMAX = SET ? 254 : 14;
  auto buildA = [&](int dl) { bf16x8 a; const int base = n + 16 * dl + r - 8 * h;
#pragma unroll
    for (int e = 0; e < 8; ++e) a[e] = (short)kr[base - e];
    return a; };
  bf16x8 a_next = buildA(DMIN);
  for (int dl = DMIN; dl <= DMAX; ++dl) {
    const bf16x8 a = a_next;
    a_next = buildA(dl + 1);
#pragma unroll
    for (int j = 0; j < NT; ++j) {
      bool valid = SET ? (dl >= 64 * j - 255 && dl <= 64 * j + 62) : true;
      if (valid) {
        int zb, sp;
        if (SET) { zb = w; sp = PAD + 1024 * j + 32 * r - 16 * dl + 8 * h; }
        else { zb = 8 * w + 4 * j + (r >> 3); sp = PAD + 32 * (r & 7) - 16 * dl + 8 * h; }
        bf16x8 bz = *(const bf16x8*)(zs + zb * ZPP + sp + 8 * (sp >> 5));
        acc[j] = mfma32(a, bz, acc[j]);
      }
    }
  }
  __syncthreads();
  constexpr int YP = n + n / 16;
  bf16_t* yb = zs;
#pragma unroll
  for (int j = 0; j < NT; ++j)
#pragma unroll
    for (int i = 0; i < 16; ++i) {
      int b, t;
      if (SET) { b = w; t = 1024 * j + 32 * r + crow(i, h); } else { b = 8 * w + 4 * j + (r >> 3); t = 32 * (r & 7) + crow(i, h); }
      yb[b * YP + t + 2 * (t >> 5)] = f2bf(acc[j][i]);
    }
  __syncthreads();
  const bf16_t* u0 = HuT + (size_t)c * MTOT + tb0; const bf16_t* HgT = (const bf16_t*)(p.ws + OFF_HGT) + (size_t)c * MTOT + tb0;
  bf16_t* dst = (bf16_t*)(p.ws + OFF_HUT) + (size_t)c * MTOT + tb0;
  bf16x8 cu[CHZ], cgt[CHZ]; float pu[CHZ], nu[CHZ];
#pragma unroll
  for (int k = 0; k < CHZ; ++k) { const int ci = tid + k * 256; const int b = ci / NC, t0 = (ci - b * NC) * 8; const int off = b * n + t0;
    cu[k] = *(const bf16x8*)(u0 + off); cgt[k] = *(const bf16x8*)(HgT + off);
    pu[k] = t0 > 0 ? bf2f(u0[off - 1]) : 0.f; nu[k] = t0 + 8 < n ? bf2f(u0[off + 8]) : 0.f; }
  __syncthreads();
#pragma unroll
  for (int k = 0; k < CHZ; ++k) { const int ci = tid + k * 256; const int b = ci / NC, t0 = (ci - b * NC) * 8; const int off = b * n + t0;
    float x[10]; x[0] = pu[k]; x[9] = nu[k];
#pragma unroll
    for (int e = 0; e < 8; ++e) x[e + 1] = bf2f((bf16_t)cu[k][e]);
    const bf16_t* yp = yb + b * YP + t0 + 2 * (t0 >> 5);
    u32x4 o;
#pragma unroll
    for (int e = 0; e < 4; ++e) {
      const float x0a = x[2 * e] * w00 + x[2 * e + 1] * w01 + x[2 * e + 2] * w02 + b0, x0b = x[2 * e + 1] * w00 + x[2 * e + 2] * w01 + x[2 * e + 3] * w02 + b0;
      o[e] = pk2(x0a * bf2f(yp[2 * e]) * bf2f((bf16_t)cgt[k][2 * e]), x0b * bf2f(yp[2 * e + 1]) * bf2f((bf16_t)cgt[k][2 * e + 1])); }
    *(u32x4*)(dst + off) = o; }
}

#define XB_TMO      128
#define XB_XCNT(j)  (256  + 64 * (j))
#define XB_XSUB(j)  (1280 + 64 * (j))
#define XB_XGEN(j)  (2304 + 64 * (j))
#define XB_TOP      3328
#define XB_TOPGEN   3392
#define XCD_BAR_WORDS 3456
#define XB_SPIN_CAP (1u << 18)
#define LAS __attribute__((address_space(3)))

__device__ __forceinline__ unsigned xb_ld(unsigned* p)              { return __hip_atomic_load(p, __ATOMIC_RELAXED, __HIP_MEMORY_SCOPE_AGENT); }
__device__ __forceinline__ unsigned xb_add(unsigned* p, unsigned v) { return __hip_atomic_fetch_add(p, v, __ATOMIC_RELAXED, __HIP_MEMORY_SCOPE_AGENT); }
__device__ __forceinline__ unsigned xb_xcc_id() { return (unsigned)__builtin_amdgcn_s_getreg((3 << 11) | 20) & 0xFu; }
#define XB_SPIN(cond, bar) do { unsigned _sp = 0; while (cond) { __builtin_amdgcn_s_sleep(1); \
    if ((++_sp & 255u) == 0u) { if (xb_ld(&(bar)[XB_TMO])) break; if (_sp > XB_SPIN_CAP) { atomicAdd(&(bar)[XB_TMO], 1u); break; } } } } while (0)

struct XcdBarrier {
    unsigned* bar; unsigned x;
    volatile LAS unsigned* st;
};

__device__ __forceinline__ XcdBarrier xcd_barrier_post(unsigned* bar, volatile LAS unsigned* st) {
    XcdBarrier b; b.bar = bar; b.x = xb_xcc_id(); b.st = st;
    if (threadIdx.x == 0) (void)xb_add(&bar[XB_XCNT(b.x)], 1u);
    return b;
}
__device__ __forceinline__ void xcd_barrier_complete(unsigned* bar, unsigned x, unsigned& nloc, unsigned& nx) {
    const unsigned G = gridDim.x * gridDim.y * gridDim.z;
    unsigned sum, cnt, mine, sp = 0u;
    for (;;) {
        sum = 0u; cnt = 0u; mine = 0u;
#pragma unroll
        for (unsigned j = 0; j < 16; ++j) { const unsigned c = xb_ld(&bar[XB_XCNT(j)]); sum += c; cnt += (c > 0u) ? 1u : 0u; mine = (j == x) ? c : mine; }
        if (sum == G) break;
        __builtin_amdgcn_s_sleep(1);
        if ((++sp & 255u) == 0u) { if (xb_ld(&bar[XB_TMO])) break; if (sp > XB_SPIN_CAP) { atomicAdd(&bar[XB_TMO], 1u); break; } }
    }
    nloc = mine > 0u ? mine : 1u; nx = cnt > 0u ? cnt : 1u;
}

__device__ __forceinline__ void xcd_barrier(const XcdBarrier& b) {
    asm volatile("s_waitcnt vmcnt(0)" ::: "memory");
    __syncthreads();
    if (threadIdx.x == 0) {
        unsigned* bar = b.bar;
        __builtin_amdgcn_s_waitcnt(0);
        unsigned nloc = b.st[0], nx = b.st[1];
        if (nloc == 0u) { xcd_barrier_complete(bar, b.x, nloc, nx); b.st[0] = nloc; b.st[1] = nx; }
        const unsigned old = xb_add(&bar[XB_XSUB(b.x)], 1u);
        const unsigned gen = old / nloc;
        if (old + 1u == (gen + 1u) * nloc) {
            __builtin_amdgcn_fence(__ATOMIC_RELEASE, "agent");
            asm volatile("s_waitcnt vmcnt(0)" ::: "memory");
            const unsigned og = xb_add(&bar[XB_TOP], 1u);
            const unsigned tg = og / nx;
            if (og + 1u == (tg + 1u) * nx) xb_add(&bar[XB_TOPGEN], 1u);
            else XB_SPIN(xb_ld(&bar[XB_TOPGEN]) == tg, bar);
            __builtin_amdgcn_fence(__ATOMIC_ACQUIRE, "agent");
            xb_add(&bar[XB_XGEN(b.x)], 1u);
            asm volatile("s_waitcnt vmcnt(0)" ::: "memory");
        } else {
            XB_SPIN(xb_ld(&bar[XB_XGEN(b.x)]) == gen, bar);
            __builtin_amdgcn_fence(__ATOMIC_ACQUIRE, "agent");
            asm volatile("s_waitcnt vmcnt(0)" ::: "memory");
        }
    }
    __syncthreads();
}

DI void run_phase(const Params& p, int ph) {
  const int bid = blockIdx.x, G = gridDim.x;
  if (ph == 0) {
    const int NTASK = 272 + 192 + 416 + 128 + 512 + 256;
    for (int t = bid; t < NTASK; t += G) {
      if (t < 272) task_filter(p, t);
      else if (t < 464) task_mod(p, t - 272);
      else if (t < 880) task_win(p, t - 464);
      else if (t < 1008) task_wout(p, t - 880);
      else if (t < 1520) task_m1(p, t - 1008);
      else task_elem(p, t - 1520, 256);
    }
  } else if (ph == 1) {
    for (int t = bid; t < 64 + MTOT / 4; t += G) { if (t < 64) task_fold(p, t); else task_prep(p, (t - 64) * 4 + (otid() >> 6)); }
  } else {
    const int l = (ph - 2) >> 2, sub = (ph - 2) & 3;
    if (sub == 0) {
      bf16x8 pra[4], prb[4];
      if ((G & 7) == 0) {
        const int x = bid & 7, jb = bid >> 3, nbx = G >> 3;
        auto tile_of = [&](int j) { const int sidx = j / 56, within = j - sidx * 56; const int mg = x + 8 * (sidx >> 2), cg = sidx & 3; return (mg * 8 + within / 7) * 28 + cg * 7 + within % 7; };
        int j = jb;
        if (j < 672) { const int t = tile_of(j); gemm_prefetch((const bf16_t*)(p.ws + OFF_H) + (size_t)(t / 28) * 128 * D, D, (const bf16_t*)(p.ws + OFF_WIT) + (size_t)l * NIN * 1024 + (size_t)(t % 28) * 128 * 1024, 1024, pra, prb); }
        for (; j < 672; j += nbx) task_inproj(p, l, tile_of(j), j + nbx < 672 ? tile_of(j + nbx) : -1, pra, prb);
      } else {
        int t = bid;
        if (t < 192 * 28) gemm_prefetch((const bf16_t*)(p.ws + OFF_H) + (size_t)(t / 28) * 128 * D, D, (const bf16_t*)(p.ws + OFF_WIT) + (size_t)l * NIN * 1024 + (size_t)(t % 28) * 128 * 1024, 1024, pra, prb);
        for (; t < 192 * 28; t += G) task_inproj(p, l, t, t + G < 192 * 28 ? t + G : -1, pra, prb);
      }
    }
    else if (sub == 1) {
      unsigned* ctr = (unsigned*)(p.ws + OFF_BAR) + XCD_BAR_WORDS + 64 * l;
      int* tslot = (int*)(smem + 81888);
      for (;;) {
        __syncthreads();
        if (otid() == 0) *tslot = (int)atomicAdd(ctr, 1u);
        __syncthreads();
        const int t = *tslot;
        if (t >= 2432) break;
        if (t < 512) { task_attn<true>(p, l, 1, t >> 7, (t >> 5) & 3, t & 31); }
        else if (t < 768) task_fnet(p, l, 1, t - 512);
        else if (t < 1024) task_hyena<1>(p, l, t - 768);
        else if (t < 1536) { int u = t - 1024; task_attn<false>(p, l, 1, u >> 7, (u >> 5) & 3, u & 31); }
        else if (t < 1792) { int u = t - 1536; task_attn<true>(p, l, 0, u >> 3, (u >> 1) & 3, u & 1); }
        else if (t < 2048) { int u = t - 1792; task_attn<false>(p, l, 0, u >> 3, (u >> 1) & 3, u & 1); }
        else if (t < 2304) task_hyena<0>(p, l, t - 2048);
        else task_fnet(p, l, 0, t - 2304);
      }
    }
    else if (sub == 2) {
      bf16x8 pra[4], prb[4];
      if ((G & 7) == 0) {
        const int x = bid & 7, jb = bid >> 3, nbx = G >> 3;
        auto tile_of = [&](int j) { const int sidx = j >> 6, within = j & 63; return ((x + 8 * sidx) * 8 + (within >> 3)) * 8 + (within & 7); };
        int j = jb;
        if (j < 192) { const int t = tile_of(j); gemm_prefetch((const bf16_t*)(p.ws + OFF_H) + (size_t)(t >> 3) * 128 * D, D, (const bf16_t*)(p.ws + OFF_WOT) + (size_t)l * 1024 * 1024 + (size_t)(t & 7) * 128 * 1024, 1024, pra, prb); }
        for (; j < 192; j += nbx) task_outproj(p, l, tile_of(j), j + nbx < 192 ? tile_of(j + nbx) : -1, pra, prb);
      } else {
        int t = bid;
        if (t < 192 * 8) gemm_prefetch((const bf16_t*)(p.ws + OFF_H) + (size_t)(t >> 3) * 128 * D, D, (const bf16_t*)(p.ws + OFF_WOT) + (size_t)l * 1024 * 1024 + (size_t)(t & 7) * 128 * 1024, 1024, pra, prb);
        for (; t < 192 * 8; t += G) task_outproj(p, l, t, t + G < 192 * 8 ? t + G : -1, pra, prb);
      }
    }
    else { for (int t = bid; t < MTOT / 8; t += G) task_final(p, l, t * 8 + (otid() >> 6) * 2); }
  }
}

__global__ void __launch_bounds__(256, 2) mega(Params p, int ph_lo, int ph_hi) {
  cg::grid_group grid = cg::this_grid();
  uint4* xb_words = (uint4*)(smem + 81904);
  if (threadIdx.x == 0) *xb_words = make_uint4(0u, 0u, 0u, 0u);
  __syncthreads();
  XcdBarrier xb = xcd_barrier_post((unsigned*)(p.ws + OFF_BAR), (volatile LAS unsigned*)xb_words);
  for (int ph = ph_lo; ph < ph_hi; ++ph) {
#ifdef REP_MASK
    if ((REP_MASK >> ph) & 1) run_phase(p, ph);
#endif
    run_phase(p, ph);
    if (ph + 1 < ph_hi) { if (ph_hi > 1000) grid.sync(); else xcd_barrier(xb); }
  }
}

extern "C" void kernel_launch(void* const* d_in, const int* in_sizes, int n_in, void* d_out, int out_size, void* d_ws, size_t ws_size, hipStream_t stream) {
  static int grid_blocks = 0;
  if (!grid_blocks) {
    int dev = 0, cus = 0, per_cu = 0; hipGetDevice(&dev);
    hipDeviceGetAttribute(&cus, hipDeviceAttributeMultiprocessorCount, dev);
    hipOccupancyMaxActiveBlocksPerMultiprocessor(&per_cu, mega, 256, 0);
    if (per_cu > 2) per_cu = 2;
    grid_blocks = cus * per_cu;
  }
  Params p{};
  for (int i = 0; i < 28; ++i) p.in[i] = (const float*)d_in[i];
  p.out = (float*)d_out; p.ws = (char*)d_ws;
#if MULTI_LAUNCH
  for (int ph = 0; ph < 10; ++ph) { int lo = ph, hi = ph + 1; hipLaunchKernelGGL(mega, dim3(grid_blocks), dim3(256), 0, stream, p, lo, hi); }
#else
  hipMemsetAsync((char*)d_ws + OFF_BAR, 0, (XCD_BAR_WORDS + 256) * sizeof(unsigned), stream);
  int lo = 0, hi = 10; void* args[] = {&p, &lo, &hi};
  hipError_t e = hipLaunchCooperativeKernel((void*)mega, dim3(grid_blocks), dim3(256), args, 0, stream);
  if (e != hipSuccess) fprintf(stderr, "cooperative launch failed: %s (grid %d)\n", hipGetErrorString(e), grid_blocks);
#endif
}
```

```cpp
#include <hip/hip_runtime.h>
#include <hip/hip_cooperative_groups.h>
#include <cstdio>
#include <cstdint>
namespace cg = cooperative_groups;

typedef unsigned short bf16_t;
typedef short bf16x8 __attribute__((ext_vector_type(8)));
typedef short s16x4 __attribute__((ext_vector_type(4)));
typedef float f32x4 __attribute__((ext_vector_type(4)));
typedef float f32x16 __attribute__((ext_vector_type(16)));
typedef unsigned u32x4 __attribute__((ext_vector_type(4)));
#define DI __device__ __forceinline__

#ifndef MULTI_LAUNCH
#define MULTI_LAUNCH 0
#endif

constexpr int D = 1024, MCTX = 8192, MLAT = 16384, MTOT = 24576, NIN = 3584, DIN = 3328;
constexpr size_t MiB = 1u << 20;
constexpr size_t OFF_H = 0, OFF_QA = 48 * MiB, OFF_KA = 60 * MiB, OFF_VAT = 66 * MiB, OFF_G = 72 * MiB, OFF_QD = 108 * MiB,
                 OFF_KD = 120 * MiB, OFF_VDT = 132 * MiB, OFF_HUT = 144 * MiB, OFF_HGT = 180 * MiB, OFF_PT = 192 * MiB,
                 OFF_O = 48 * MiB, OFF_WIT = 216 * MiB, OFF_WOT = 230 * MiB, OFF_WFU = 234 * MiB, OFF_M1T = 235 * MiB,
                 OFF_FILT = 236 * MiB, OFF_KCA = 245 * MiB, OFF_VCAT = 246 * MiB, OFF_KCD = 247 * MiB, OFF_VCDT = 249 * MiB,
                 OFF_COSA = 251 * MiB, OFF_SINA = 251 * MiB + 512 * 1024, OFF_COSD = 252 * MiB, OFF_SIND = 252 * MiB + 256 * 1024,
                 OFF_MOD = 252 * MiB + 512 * 1024, OFF_BAR = 253 * MiB;
constexpr int FILT_L = 512 * 256 + 512 * 4096;
constexpr int OUT_AK = MTOT * D, OUT_AV = OUT_AK + 2097152, OUT_DK = OUT_AV + 2097152, OUT_DV = OUT_DK + 4194304;

struct Params { const float* in[28]; float* out; char* ws; };

DI float bf2f(bf16_t b) { return __uint_as_float(((unsigned)b) << 16); }
typedef float f32x2 __attribute__((ext_vector_type(2)));
typedef __bf16 hbf2 __attribute__((ext_vector_type(2)));
DI unsigned pk2(float a, float b) { f32x2 v = {a, b}; hbf2 r = __builtin_convertvector(v, hbf2); return __builtin_bit_cast(unsigned, r); }
DI bf16_t f2bf(float x) { return (bf16_t)(pk2(x, 0.f) & 0xffffu); }
DI float silu(float x) { return x / (1.f + __expf(-x)); }
DI f32x16 mfma32(bf16x8 a, bf16x8 b, f32x16 c) { return __builtin_amdgcn_mfma_f32_32x32x16_bf16(a, b, c, 0, 0, 0); }
DI f32x4 mfma16(bf16x8 a, bf16x8 b, f32x4 c) { return __builtin_amdgcn_mfma_f32_16x16x32_bf16(a, b, c, 0, 0, 0); }
DI int crow(int reg, int h) { return (reg & 3) + 8 * (reg >> 2) + 4 * h; }
DI int otid() { int t = threadIdx.x; asm volatile("" : "+v"(t)); return t; }
DI float wave_sum(float v) { for (int o = 32; o > 0; o >>= 1) v += __shfl_xor(v, o); return v; }

__shared__ __attribute__((aligned(16))) char smem[81920];

struct LdPlain { const bf16_t* p; size_t ld;
  DI bf16x8 operator()(int row, int k) const { return *(const bf16x8*)(p + (size_t)row * ld + k); } };

template <bool SWAP, bool AROW = false, class LA, class LB>
DI void gemm_core(f32x4 (&acc)[4][4], const LA& la, const LB& lb, int nk, bf16x8 (&ra0)[4], bf16x8 (&rb0)[4], bool preloaded) {
  bf16_t* sA = (bf16_t*)smem; bf16_t* sB = (bf16_t*)(smem + 16384);
  const int tid = otid(), lane = tid & 63, wid = tid >> 6, wr = wid >> 1, wc = wid & 1, fr = lane & 15, fq = lane >> 4;
#pragma unroll
  for (int i = 0; i < 4; ++i)
#pragma unroll
    for (int j = 0; j < 4; ++j) acc[i][j] = f32x4{0.f, 0.f, 0.f, 0.f};
  auto gl = [&](int kt, bf16x8 (&ra)[4], bf16x8 (&rb)[4]) {
#pragma unroll
    for (int i = 0; i < 4; ++i) { int id = tid + i * 256; int row = id >> 3, kc = (id & 7) * 8; rb[i] = lb(row, kt * 64 + kc);
      if (AROW) { row = tid >> 1; kc = ((tid & 1) * 4 + i) * 8; } ra[i] = la(row, kt * 64 + kc); } };
  auto lw = [&](bf16x8 (&ra)[4], bf16x8 (&rb)[4]) {
#pragma unroll
    for (int i = 0; i < 4; ++i) { int id = tid + i * 256; int row = id >> 3, kc = (id & 7) * 8;
      *(bf16x8*)(sB + row * 64 + (kc ^ (((row >> 1) & 7) * 8))) = rb[i]; if (AROW) { row = tid >> 1; kc = ((tid & 1) * 4 + i) * 8; } *(bf16x8*)(sA + row * 64 + (kc ^ (((row >> 1) & 7) * 8))) = ra[i]; } };
  auto comp = [&]() {
#pragma unroll
    for (int ks = 0; ks < 2; ++ks) {
      bf16x8 a[4], b[4];
#pragma unroll
      for (int mi = 0; mi < 4; ++mi) a[mi] = *(const bf16x8*)(sA + (wr * 64 + mi * 16 + fr) * 64 + (((ks * 4 + fq) ^ ((fr >> 1) & 7)) * 8));
#pragma unroll
      for (int ni = 0; ni < 4; ++ni) b[ni] = *(const bf16x8*)(sB + (wc * 64 + ni * 16 + fr) * 64 + (((ks * 4 + fq) ^ ((fr >> 1) & 7)) * 8));
#pragma unroll
      for (int mi = 0; mi < 4; ++mi)
#pragma unroll
        for (int ni = 0; ni < 4; ++ni) acc[mi][ni] = SWAP ? mfma16(b[ni], a[mi], acc[mi][ni]) : mfma16(a[mi], b[ni], acc[mi][ni]);
    } };
  if (!preloaded) gl(0, ra0, rb0);
#pragma unroll 1
  for (int kt = 0; kt < nk; ++kt) {
    __syncthreads();
    lw(ra0, rb0);
    __syncthreads();
    if (kt + 1 < nk) gl(kt + 1, ra0, rb0);
    __builtin_amdgcn_sched_barrier(0);
    comp();
  }
  __syncthreads();
}

template <bool SWAP, class LA, class LB>
DI void gemm_core(f32x4 (&acc)[4][4], const LA& la, const LB& lb, int nk) { bf16x8 ra0[4], rb0[4]; gemm_core<SWAP>(acc, la, lb, nk, ra0, rb0, false); }
DI void gemm_prefetch(const bf16_t* A, size_t lda, const bf16_t* B, size_t ldb, bf16x8 (&ra)[4], bf16x8 (&rb)[4]) {
  const int tid = otid();
#pragma unroll
  for (int i = 0; i < 4; ++i) { int id = tid + i * 256; int row = id >> 3, kc = (id & 7) * 8; ra[i] = *(const bf16x8*)(A + (size_t)row * lda + kc); rb[i] = *(const bf16x8*)(B + (size_t)row * ldb + kc); }
  __builtin_amdgcn_sched_barrier(0);
}

template <bool SWAP, class LA, class LB>
DI void gemm_core_db(f32x4 (&acc)[4][4], const LA& la, const LB& lb, int nk, bf16x8 (&ra0)[4], bf16x8 (&rb0)[4], bool preloaded) {
  const int tid = otid(), lane = tid & 63, wid = tid >> 6, wr = wid >> 1, wc = wid & 1, fr = lane & 15, fq = lane >> 4;
#pragma unroll
  for (int i = 0; i < 4; ++i)
#pragma unroll
    for (int j = 0; j < 4; ++j) acc[i][j] = f32x4{0.f, 0.f, 0.f, 0.f};
  auto gl = [&](int kt, bf16x8 (&ra)[4], bf16x8 (&rb)[4]) {
#pragma unroll
    for (int i = 0; i < 4; ++i) { int id = tid + i * 256; int row = id >> 3, kc = (id & 7) * 8; ra[i] = la(row, kt * 64 + kc); rb[i] = lb(row, kt * 64 + kc); } };
  auto lw = [&](int st, bf16x8 (&ra)[4], bf16x8 (&rb)[4]) {
    bf16_t* sA = (bf16_t*)(smem + st * 36864); bf16_t* sB = (bf16_t*)(smem + st * 36864 + 16384);
#pragma unroll
    for (int i = 0; i < 4; ++i) { int id = tid + i * 256; int row = id >> 3, kc = (id & 7) * 8;
      *(bf16x8*)(sA + row * 64 + (kc ^ (((row >> 1) & 7) * 8))) = ra[i]; *(bf16x8*)(sB + row * 64 + (kc ^ (((row >> 1) & 7) * 8))) = rb[i]; } };
  auto comp = [&](int st) {
    const bf16_t* sA = (const bf16_t*)(smem + st * 36864); const bf16_t* sB = (const bf16_t*)(smem + st * 36864 + 16384);
#pragma unroll
    for (int ks = 0; ks < 2; ++ks) {
      bf16x8 a[4], b[4];
#pragma unroll
      for (int mi = 0; mi < 4; ++mi) a[mi] = *(const bf16x8*)(sA + (wr * 64 + mi * 16 + fr) * 64 + (((ks * 4 + fq) ^ ((fr >> 1) & 7)) * 8));
#pragma unroll
      for (int ni = 0; ni < 4; ++ni) b[ni] = *(const bf16x8*)(sB + (wc * 64 + ni * 16 + fr) * 64 + (((ks * 4 + fq) ^ ((fr >> 1) & 7)) * 8));
#pragma unroll
      for (int mi = 0; mi < 4; ++mi)
#pragma unroll
        for (int ni = 0; ni < 4; ++ni) acc[mi][ni] = SWAP ? mfma16(b[ni], a[mi], acc[mi][ni]) : mfma16(a[mi], b[ni], acc[mi][ni]);
    } };
  if (!preloaded) gl(0, ra0, rb0);
  __syncthreads();
  lw(0, ra0, rb0);
  if (nk > 1) gl(1, ra0, rb0);
  __syncthreads();
#pragma unroll 1
  for (int kt = 0; kt < nk; kt += 2) {
    if (kt + 1 < nk) lw(1, ra0, rb0);
    if (kt + 2 < nk) gl(kt + 2, ra0, rb0);
    __builtin_amdgcn_sched_barrier(0);
    comp(0);
    __syncthreads();
    if (kt + 1 < nk) {
      if (kt + 2 < nk) lw(0, ra0, rb0);
      if (kt + 3 < nk) gl(kt + 3, ra0, rb0);
      __builtin_amdgcn_sched_barrier(0);
      comp(1);
      __syncthreads();
    }
  }
}

#define LDS_AS __attribute__((address_space(3)))
template <bool SWAP>
DI void gemm_core_dma(f32x4 (&acc)[4][4], const bf16_t* A, int lda, const bf16_t* B, int ldb, int nk) {
  const int tid = otid(), lane = tid & 63, wid = tid >> 6, wr = wid >> 1, wc = wid & 1, fr = lane & 15, fq = lane >> 4;
#pragma unroll
  for (int i = 0; i < 4; ++i)
#pragma unroll
    for (int j = 0; j < 4; ++j) acc[i][j] = f32x4{0.f, 0.f, 0.f, 0.f};
  unsigned offa[4], offb[4];
#pragma unroll
  for (int i = 0; i < 4; ++i) { const int L = (wid * 4 + i) * 64 + lane; const int row = L >> 3, pos = L & 7; const int c = pos ^ ((row >> 1) & 7);
    offa[i] = (unsigned)(row * lda + c * 8); offb[i] = (unsigned)(row * ldb + c * 8); }
  auto dma = [&](int st, int kt) {
#pragma unroll
    for (int i = 0; i < 4; ++i) { const int L0 = (wid * 4 + i) * 64;
      __builtin_amdgcn_global_load_lds((const unsigned*)(A + offa[i] + kt * 64), (LDS_AS unsigned*)(smem + st * 36864 + L0 * 16), 16, 0, 0);
      __builtin_amdgcn_global_load_lds((const unsigned*)(B + offb[i] + kt * 64), (LDS_AS unsigned*)(smem + st * 36864 + 16384 + L0 * 16), 16, 0, 0); } };
  auto comp = [&](int st) {
    const bf16_t* sA = (const bf16_t*)(smem + st * 36864); const bf16_t* sB = (const bf16_t*)(smem + st * 36864 + 16384);
#pragma unroll
    for (int ks = 0; ks < 2; ++ks) {
      bf16x8 a[4], b[4];
#pragma unroll
      for (int mi = 0; mi < 4; ++mi) a[mi] = *(const bf16x8*)(sA + (wr * 64 + mi * 16 + fr) * 64 + (((ks * 4 + fq) ^ ((fr >> 1) & 7)) * 8));
#pragma unroll
      for (int ni = 0; ni < 4; ++ni) b[ni] = *(const bf16x8*)(sB + (wc * 64 + ni * 16 + fr) * 64 + (((ks * 4 + fq) ^ ((fr >> 1) & 7)) * 8));
#pragma unroll
      for (int mi = 0; mi < 4; ++mi)
#pragma unroll
        for (int ni = 0; ni < 4; ++ni) acc[mi][ni] = SWAP ? mfma16(b[ni], a[mi], acc[mi][ni]) : mfma16(a[mi], b[ni], acc[mi][ni]);
    } };
  __syncthreads();
  dma(0, 0);
  asm volatile("s_waitcnt vmcnt(0)" ::: "memory");
  __syncthreads();
#pragma unroll 1
  for (int kt = 0; kt < nk; kt += 2) {
    dma(1, kt + 1);
    comp(0);
    asm volatile("s_waitcnt vmcnt(0)" ::: "memory");
    __syncthreads();
    if (kt + 2 < nk) dma(0, kt + 2);
    comp(1);
    asm volatile("s_waitcnt vmcnt(0)" ::: "memory");
    __syncthreads();
  }
}

DI void gemm_core_outproj(f32x4 (&acc)[4][4], const bf16_t* A, int lda, const bf16_t* B, int ldb, const bf16_t* AT, int tok0) {
  constexpr int nk = 16;
  const int tid = otid(), lane = tid & 63, wid = tid >> 6, wr = wid >> 1, wc = wid & 1, fr = lane & 15, fq = lane >> 4;
#pragma unroll
  for (int i = 0; i < 4; ++i)
#pragma unroll
    for (int j = 0; j < 4; ++j) acc[i][j] = f32x4{0.f, 0.f, 0.f, 0.f};
  unsigned offa[4], offb[4];
#pragma unroll
  for (int i = 0; i < 4; ++i) { const int L = (wid * 4 + i) * 64 + lane; const int row = L >> 3, pos = L & 7; const int c = pos ^ ((row >> 1) & 7);
    offa[i] = (unsigned)(row * lda + c * 8); offb[i] = (unsigned)(row * ldb + c * 8); }
  bf16x8 tr[4];
  auto fill = [&](int st, int kt) {
    const bool T = (kt >= 8 && kt < 12);
#pragma unroll
    for (int i = 0; i < 4; ++i) { const int L0 = (wid * 4 + i) * 64;
      if (!T) __builtin_amdgcn_global_load_lds((const unsigned*)(A + offa[i] + kt * 64), (LDS_AS unsigned*)(smem + st * 36864 + L0 * 16), 16, 0, 0);
      __builtin_amdgcn_global_load_lds((const unsigned*)(B + offb[i] + kt * 64), (LDS_AS unsigned*)(smem + st * 36864 + 16384 + L0 * 16), 16, 0, 0); }
    if (T) {
#pragma unroll
      for (int i = 0; i < 4; ++i) { const int id = tid + i * 256; const int ch = id >> 4, tc = (id & 15) * 8;
        tr[i] = *(const bf16x8*)(AT + (size_t)((kt - 8) * 64 + ch) * MTOT + tok0 + tc); }
    } };
  auto fillT = [&](int st, int kt) {
    if (kt >= 8 && kt < 12) {
      char* sA = smem + st * 36864;
#pragma unroll
      for (int i = 0; i < 4; ++i) { const int id = tid + i * 256; const int ch = id >> 4, tc = (id & 15) * 8;
#pragma unroll
        for (int e = 0; e < 8; ++e) { const int row = tc + e; *(bf16_t*)(sA + row * 128 + (((ch >> 3) ^ ((row >> 1) & 7)) * 16) + (ch & 7) * 2) = (bf16_t)tr[i][e]; } }
    } };
  auto comp = [&](int st) {
    const bf16_t* sA = (const bf16_t*)(smem + st * 36864); const bf16_t* sB = (const bf16_t*)(smem + st * 36864 + 16384);
#pragma unroll
    for (int ks = 0; ks < 2; ++ks) {
      bf16x8 a[4], b[4];
#pragma unroll
      for (int mi = 0; mi < 4; ++mi) a[mi] = *(const bf16x8*)(sA + (wr * 64 + mi * 16 + fr) * 64 + (((ks * 4 + fq) ^ ((fr >> 1) & 7)) * 8));
#pragma unroll
      for (int ni = 0; ni < 4; ++ni) b[ni] = *(const bf16x8*)(sB + (wc * 64 + ni * 16 + fr) * 64 + (((ks * 4 + fq) ^ ((fr >> 1) & 7)) * 8));
#pragma unroll
      for (int mi = 0; mi < 4; ++mi)
#pragma unroll
        for (int ni = 0; ni < 4; ++ni) acc[mi][ni] = mfma16(b[ni], a[mi], acc[mi][ni]);
    } };
  __syncthreads();
  fill(0, 0);
  asm volatile("s_waitcnt vmcnt(0)" ::: "memory");
  __syncthreads();
#pragma unroll 1
  for (int kt = 0; kt < nk; kt += 2) {
    fill(1, kt + 1);
    comp(0);
    fillT(1, kt + 1);
    asm volatile("s_waitcnt vmcnt(0)" ::: "memory");
    __syncthreads();
    if (kt + 2 < nk) fill(0, kt + 2);
    comp(1);
    if (kt + 2 < nk) fillT(0, kt + 2);
    asm volatile("s_waitcnt vmcnt(0)" ::: "memory");
    __syncthreads();
  }
}

template <class F>
DI void stage_T(f32x4 (&acc)[4][4], F f) {
  bf16_t* sC = (bf16_t*)smem;
  const int tid = otid(), lane = tid & 63, wid = tid >> 6, wr = wid >> 1, wc = wid & 1, fr = lane & 15, fq = lane >> 4;
#pragma unroll
  for (int mi = 0; mi < 4; ++mi)
#pragma unroll
    for (int ni = 0; ni < 4; ++ni) { const int row = wr * 64 + mi * 16 + fq * 4, col = wc * 64 + ni * 16 + fr;
      uint2 v; v.x = pk2(f(col, acc[mi][ni][0]), f(col, acc[mi][ni][1])); v.y = pk2(f(col, acc[mi][ni][2]), f(col, acc[mi][ni][3]));
      *(uint2*)(sC + col * 136 + row) = v; }
  __syncthreads();
}
template <class F>
DI void stage_R(f32x4 (&acc)[4][4], F f) {
  bf16_t* sC = (bf16_t*)smem;
  const int tid = otid(), lane = tid & 63, wid = tid >> 6, wr = wid >> 1, wc = wid & 1, fr = lane & 15, fq = lane >> 4;
#pragma unroll
  for (int mi = 0; mi < 4; ++mi)
#pragma unroll
    for (int ni = 0; ni < 4; ++ni) { const int row = wr * 64 + mi * 16 + fr, col = wc * 64 + ni * 16 + fq * 4;
      uint2 v; v.x = pk2(f(col, acc[mi][ni][0]), f(col + 1, acc[mi][ni][1])); v.y = pk2(f(col + 2, acc[mi][ni][2]), f(col + 3, acc[mi][ni][3]));
      *(uint2*)(sC + row * 136 + col) = v; }
  __syncthreads();
}
DI void store_img(bf16_t* dst, size_t ld) {
  const bf16_t* sC = (const bf16_t*)smem; const int tid = otid();
#pragma unroll
  for (int i = 0; i < 8; ++i) { const int id = tid + i * 256; const int r = id >> 4, c = (id & 15) * 8;
    *(bf16x8*)(dst + (size_t)r * ld + c) = *(const bf16x8*)(sC + r * 136 + c); }
}
template <int HD>
DI void store_rope(bf16_t* dst, size_t ld, int pos0, const float* cs, const float* sn) {
  const bf16_t* sC = (const bf16_t*)smem; const int tid = otid();
  constexpr int HALF = HD / 2, CPH = HALF / 8;
#pragma unroll
  for (int k = 0; k < 4; ++k) { const int id = tid + k * 256; const int r = id >> 3, q = id & 7; const int head = q / CPH, i8 = q % CPH; const int pos = pos0 + r;
    const int cbase = head * HD + i8 * 8;
    const bf16x8 x1 = *(const bf16x8*)(sC + r * 136 + cbase), x2 = *(const bf16x8*)(sC + r * 136 + cbase + HALF);
    const float4* cp = (const float4*)(cs + pos * HALF + i8 * 8); const float4* sp = (const float4*)(sn + pos * HALF + i8 * 8);
    const float4 c0 = cp[0], c1 = cp[1], s0 = sp[0], s1 = sp[1];
    const float cc[8] = {c0.x, c0.y, c0.z, c0.w, c1.x, c1.y, c1.z, c1.w}, ss[8] = {s0.x, s0.y, s0.z, s0.w, s1.x, s1.y, s1.z, s1.w};
    u32x4 o1, o2;
#pragma unroll
    for (int e = 0; e < 4; ++e) {
      const float a0 = bf2f((bf16_t)x1[2 * e]), b0 = bf2f((bf16_t)x2[2 * e]), a1 = bf2f((bf16_t)x1[2 * e + 1]), b1 = bf2f((bf16_t)x2[2 * e + 1]);
      o1[e] = pk2(a0 * cc[2 * e] - b0 * ss[2 * e], a1 * cc[2 * e + 1] - b1 * ss[2 * e + 1]);
      o2[e] = pk2(a0 * ss[2 * e] + b0 * cc[2 * e], a1 * ss[2 * e + 1] + b1 * cc[2 * e + 1]); }
    *(u32x4*)(dst + (size_t)r * ld + cbase) = o1; *(u32x4*)(dst + (size_t)r * ld + cbase + HALF) = o2; }
}
template <bool SWAP>
DI void store_acc_f32(f32x4 (&acc)[4][4], float* dst, size_t ld) {
  const int tid = otid(), lane = tid & 63, wid = tid >> 6, wr = wid >> 1, wc = wid & 1, fr = lane & 15, fq = lane >> 4;
#pragma unroll
  for (int mi = 0; mi < 4; ++mi)
#pragma unroll
    for (int ni = 0; ni < 4; ++ni) {
      if (SWAP) { const int row = wr * 64 + mi * 16 + fr, col = wc * 64 + ni * 16 + fq * 4; *(f32x4*)(dst + (size_t)row * ld + col) = acc[mi][ni]; }
      else {
#pragma unroll
        for (int j = 0; j < 4; ++j) { const int row = wr * 64 + mi * 16 + fq * 4 + j, col = wc * 64 + ni * 16 + fr; dst[(size_t)row * ld + col] = acc[mi][ni][j]; } }
    }
}

DI void task_mod(const Params& p, int t) {
  int l = t / 96, j0 = (t % 96) * 32; float* sc = (float*)smem;
  __syncthreads();
  for (int i = otid(); i < 5 * 1024; i += 256) { int r = i >> 10, k = i & 1023; float v = r == 0 ? p.in[7][k] : p.in[6][(r - 1) * 1024 + k]; sc[i] = silu(v); }
  __syncthreads();
  int col = otid() & 31, ks = otid() >> 5; const float* w = p.in[8] + (size_t)l * 1024 * 3072 + j0 + col;
  float a[5] = {0, 0, 0, 0, 0};
#pragma unroll 16
  for (int k = ks * 128; k < ks * 128 + 128; ++k) { float wv = w[(size_t)k * 3072];
#pragma unroll
    for (int r = 0; r < 5; ++r) a[r] += sc[r * 1024 + k] * wv; }
  float* red = sc + 5120;
#pragma unroll
  for (int r = 0; r < 5; ++r) red[(ks * 5 + r) * 32 + col] = a[r];
  __syncthreads();
  for (int i = otid(); i < 160; i += 256) { int r = i >> 5, c = i & 31; float s = 0.f;
#pragma unroll
    for (int q = 0; q < 8; ++q) s += red[(q * 5 + r) * 32 + c];
    ((float*)(p.ws + OFF_MOD))[(l * 5 + r) * 3072 + j0 + c] = s + p.in[9][l * 3072 + j0 + c]; }
}
DI void task_transpose(const float* src, size_t ld, bf16_t* dst, size_t ldd) {
  bf16_t* tl = (bf16_t*)smem;
  const int tid = otid();
  __syncthreads();
#pragma unroll 4
  for (int i0 = 0; i0 < 64; i0 += 16) {
    float v[16];
#pragma unroll
    for (int u = 0; u < 16; ++u) v[u] = src[(size_t)(i0 + u) * ld + tid];
#pragma unroll
    for (int u = 0; u < 16; ++u) tl[tid * 72 + i0 + u] = f2bf(v[u]);
  }
  __syncthreads();
#pragma unroll
  for (int i = 0; i < 8; ++i) { const int id = tid + i * 256; const int n = id >> 3, kc = (id & 7) * 8; *(bf16x8*)(dst + (size_t)n * ldd + kc) = *(const bf16x8*)(tl + n * 72 + kc); }
}
DI void task_win(const Params& p, int t) {
  const int l = t / 208, r = t % 208, kt = r / 13, nt = r % 13, k0 = kt * 64, n0 = nt * 256;
  const float* src = p.in[12] + (size_t)l * 1024 * DIN + (size_t)k0 * DIN + n0;
  if (nt == 11) {
    bf16_t* dst = (bf16_t*)(p.ws + OFF_WFU) + (size_t)l * 1024 * 256 + (size_t)k0 * 256; const int tid = otid();
#pragma unroll 16
    for (int rr = 0; rr < 64; ++rr) dst[(size_t)rr * 256 + tid] = f2bf(src[(size_t)rr * DIN + tid]);
    return;
  }
  const int nd = n0 < 2816 ? n0 : n0 + 256;
  task_transpose(src, DIN, (bf16_t*)(p.ws + OFF_WIT) + (size_t)l * NIN * 1024 + (size_t)nd * 1024 + k0, 1024);
}
DI void task_wout(const Params& p, int t) {
  const int l = t / 64, r = t % 64, kt = r / 4, nt = r % 4;
  task_transpose(p.in[13] + (size_t)l * 1024 * 1024 + (size_t)kt * 64 * 1024 + nt * 256, 1024,
                 (bf16_t*)(p.ws + OFF_WOT) + (size_t)l * 1024 * 1024 + (size_t)nt * 256 * 1024 + kt * 64, 1024);
}
DI void task_m1(const Params& p, int t) {
  int l = t >> 8, cp = t & 255, g = cp >> 6, c = cp & 63; float* cs = (float*)smem; float* sn = cs + 64;
  __syncthreads();
  if (otid() < 64) { int m = otid(); int ph = (m * c) & 63; cs[m] = cospif(ph / 32.f); sn[m] = sinpif(ph / 32.f); }
  __syncthreads();
  const float* fw = p.in[26] + (size_t)l * 65536 + (size_t)(g * 64) * 256; int j = otid();
  float ac = 0, as = 0;
  for (int m = 0; m < 64; ++m) { float w = fw[m * 256 + j]; ac += cs[m] * w; as += sn[m] * w; }
  bf16_t* m1 = (bf16_t*)(p.ws + OFF_M1T) + (size_t)l * 512 * 256;
  m1[(size_t)j * 256 + cp] = f2bf(ac); m1[(size_t)(256 + j) * 256 + cp] = f2bf(as);
}
DI void task_filter(const Params& p, int t2) {
  const int t = t2 >> 1, half0 = t2 & 1;
  int l = t / 68, r = t % 68, set = r >= 4, pb = set ? r - 4 : r, n = set ? 4096 : 256, p0 = pb * 64;
  float* feats = (float*)smem; float* h1 = feats + 64 * 33; float* h2 = h1 + 64 * 64;
  bf16_t* stg = (bf16_t*)(smem + 41216);
  const int tid = otid(); const int pp0 = tid & 63, grp = tid >> 6;
  __syncthreads();
  { const int pos = p0 + pp0; float tt = (float)pos / (float)(n - 1); float w = (6.283185307179586f / (float)n) * (float)pos;
    for (int i = grp; i < 33; i += 4) { float v;
      if (i == 0) v = tt; else { int j = (i - 1) & 15; float f = 1e-4f + (float)j * ((15.f - 1e-4f) / 15.f); v = i <= 16 ? cosf(f * w) : -sinf(f * w); }
      feats[pp0 * 33 + i] = v; } }
  __syncthreads();
  const float* w1 = p.in[19] + l * 33 * 64; const float* b1 = p.in[20] + l * 64; const float* w2 = p.in[21] + l * 4096; const float* b2 = p.in[22] + l * 64;
  const float* w3 = p.in[23] + (size_t)l * 64 * 512; const float* fr = p.in[24] + l * 64;
  const int j = tid & 63, pg = tid >> 6;
  { float wc[33];
#pragma unroll
    for (int i = 0; i < 33; ++i) wc[i] = w1[i * 64 + j];
    const float bj = b1[j], fj = fr[j];
    for (int pp = pg * 16; pp < pg * 16 + 16; ++pp) { float a = bj;
#pragma unroll
      for (int i = 0; i < 33; ++i) a += feats[pp * 33 + i] * wc[i];
      h1[pp * 64 + j] = sinf(fj * a); } }
  __syncthreads();
  { float wc[64];
#pragma unroll
    for (int i = 0; i < 64; ++i) wc[i] = w2[i * 64 + j];
    const float bj = b2[j], fj = fr[j];
    for (int pp = pg * 16; pp < pg * 16 + 16; ++pp) { float a = bj;
#pragma unroll
      for (int i = 0; i < 64; ++i) a += h1[pp * 64 + i] * wc[i];
      h2[pp * 64 + j] = sinf(fj * a); } }
  __syncthreads();
  bf16_t* F = (bf16_t*)(p.ws + OFF_FILT) + (size_t)l * FILT_L + (set ? 512 * 256 : 0);
  for (int half = half0; half <= half0; ++half) {
    const int o = half * 256 + tid; float wc[64];
#pragma unroll
    for (int k = 0; k < 64; ++k) wc[k] = w3[k * 512 + o];
    const int c = o & 255; const float delta = fabsf(-3.0701134573253945f + (-15.350567286626973f + 3.0701134573253945f) * ((float)c / 255.f));
    for (int pp = 0; pp < 64; ++pp) { float a = 0.f;
#pragma unroll
      for (int k = 0; k < 64; ++k) a += h2[pp * 64 + k] * wc[k];
      float tt = (float)(p0 + pp) / (float)(n - 1);
      stg[tid * 72 + pp] = f2bf(a * expf(-tt * delta)); }
    __syncthreads();
#pragma unroll
    for (int i = 0; i < 8; ++i) { int id = tid + i * 256; int row = id >> 3, pc = (id & 7) * 8;
      *(bf16x8*)(F + (size_t)(half * 256 + row) * n + p0 + pc) = *(const bf16x8*)(stg + row * 72 + pc); }
    __syncthreads();
  }
}
DI void task_elem(const Params& p, int t, int nt) {
  const int stride = nt * 256; const int g0 = t * 256 + otid();
  bf16_t* kca = (bf16_t*)(p.ws + OFF_KCA); bf16_t* vcat = (bf16_t*)(p.ws + OFF_VCAT); bf16_t* kcd = (bf16_t*)(p.ws + OFF_KCD); bf16_t* vcdt = (bf16_t*)(p.ws + OFF_VCDT);
  for (int i = g0; i < 4 * 2 * 512 * 128; i += stride) {
    kca[i] = f2bf(p.in[2][i]);
    int n = i & 511, ch = (i >> 9) & 127, bl = i >> 16; vcat[i] = f2bf(p.in[3][((size_t)bl * 512 + n) * 128 + ch]);
  }
  for (int i = g0; i < 4 * 2 * 512 * 256; i += stride) {
    kcd[i] = f2bf(p.in[4][i]);
    int n = i & 511, ch = (i >> 9) & 255, bl = i >> 17; vcdt[i] = f2bf(p.in[5][((size_t)bl * 512 + n) * 256 + ch]);
  }
  float* cosA = (float*)(p.ws + OFF_COSA); float* sinA = (float*)(p.ws + OFF_SINA); float* cosD = (float*)(p.ws + OFF_COSD); float* sinD = (float*)(p.ws + OFF_SIND);
  for (int i = g0; i < 4096 * 32; i += stride) { int pos = i >> 5, k = i & 31; float base = k < 16 ? (float)(pos >> 6) : (float)(pos & 63); int f = k & 15;
    float inv = powf(10000.f, -(float)f / 16.f); float ang = base * inv; cosA[i] = cosf(ang); sinA[i] = sinf(ang); }
  for (int i = g0; i < 4096 * 16; i += stride) { int pos = i >> 4, k = i & 15; float base = k < 8 ? (float)(pos >> 6) : (float)(pos & 63); int f = k & 7;
    float inv = powf(10000.f, -(float)f / 8.f); float ang = base * inv; cosD[i] = cosf(ang); sinD[i] = sinf(ang); }
}

DI int modrow(int row) { return row < MCTX ? 0 : 1 + ((row - MCTX) >> 12); }
DI const float* xrow_in(const Params& p, int row) { return row < MCTX ? p.in[0] + (size_t)row * D : p.in[1] + (size_t)(row - MCTX) * D; }
DI void task_prep(const Params& p, int row) {
  const int lane = otid() & 63; const float* x = xrow_in(p, row); const float* mod = (const float*)(p.ws + OFF_MOD) + (size_t)(0 * 5 + modrow(row)) * 3072;
  float v[16]; float ss = 0;
#pragma unroll
  for (int j = 0; j < 2; ++j) { const float4* s = (const float4*)(x + lane * 8 + 512 * j); float4 a = s[0], b = s[1];
    v[j * 8 + 0] = a.x; v[j * 8 + 1] = a.y; v[j * 8 + 2] = a.z; v[j * 8 + 3] = a.w; v[j * 8 + 4] = b.x; v[j * 8 + 5] = b.y; v[j * 8 + 6] = b.z; v[j * 8 + 7] = b.w; }
#pragma unroll
  for (int i = 0; i < 16; ++i) ss += v[i] * v[i];
  ss = wave_sum(ss); float rn = rsqrtf(ss * (1.f / 1024.f) + 1e-6f);
  bf16_t* H = (bf16_t*)(p.ws + OFF_H) + (size_t)row * D;
#pragma unroll
  for (int j = 0; j < 2; ++j) { bf16x8 o;
#pragma unroll
    for (int e = 0; e < 8; ++e) { int c = lane * 8 + 512 * j + e; o[e] = (short)f2bf(v[j * 8 + e] * rn * p.in[10][c] * (1.f + mod[1024 + c]) + mod[c]); }
    *(bf16x8*)(H + lane * 8 + 512 * j) = o; }
}
DI void task_final(const Params& p, int l, int row0) {
  const int lane = otid() & 63; const int mr = modrow(row0);
  const float* mod = (const float*)(p.ws + OFF_MOD) + (size_t)(l * 5 + mr) * 3072;
  float ov[2][16], xv[2][16];
#pragma unroll
  for (int rr = 0; rr < 2; ++rr) { const int row = row0 + rr;
    const float* x = l == 0 ? xrow_in(p, row) : p.out + (size_t)row * D; const bf16_t* o = (const bf16_t*)(p.ws + OFF_O) + (size_t)row * D;
#pragma unroll
    for (int j = 0; j < 2; ++j) { bf16x8 t = *(const bf16x8*)(o + lane * 8 + 512 * j);
#pragma unroll
      for (int e = 0; e < 8; ++e) ov[rr][j * 8 + e] = bf2f((bf16_t)t[e]);
      const float4* s = (const float4*)(x + lane * 8 + 512 * j); float4 a = s[0], b = s[1];
      xv[rr][j * 8 + 0] = a.x; xv[rr][j * 8 + 1] = a.y; xv[rr][j * 8 + 2] = a.z; xv[rr][j * 8 + 3] = a.w; xv[rr][j * 8 + 4] = b.x; xv[rr][j * 8 + 5] = b.y; xv[rr][j * 8 + 6] = b.z; xv[rr][j * 8 + 7] = b.w; } }
  float gp[16];
#pragma unroll
  for (int j = 0; j < 2; ++j)
#pragma unroll
    for (int e = 0; e < 8; ++e) { const int c = lane * 8 + 512 * j + e; gp[j * 8 + e] = mod[2048 + c] * p.in[11][l * 1024 + c]; }
  const float* mod1 = (const float*)(p.ws + OFF_MOD) + (size_t)(5 + mr) * 3072;
#pragma unroll
  for (int rr = 0; rr < 2; ++rr) { const int row = row0 + rr;
    float ss = 0;
#pragma unroll
    for (int i = 0; i < 16; ++i) ss += ov[rr][i] * ov[rr][i];
    ss = wave_sum(ss); const float rn = rsqrtf(ss * (1.f / 1024.f) + 1e-6f); float s2 = 0;
#pragma unroll
    for (int i = 0; i < 16; ++i) { const float y = xv[rr][i] + gp[i] * (ov[rr][i] * rn); xv[rr][i] = y; s2 += y * y; }
    float* dst = p.out + (size_t)row * D;
#pragma unroll
    for (int j = 0; j < 2; ++j) { float4* d = (float4*)(dst + lane * 8 + 512 * j);
      d[0] = make_float4(xv[rr][j * 8 + 0], xv[rr][j * 8 + 1], xv[rr][j * 8 + 2], xv[rr][j * 8 + 3]); d[1] = make_float4(xv[rr][j * 8 + 4], xv[rr][j * 8 + 5], xv[rr][j * 8 + 6], xv[rr][j * 8 + 7]); }
    if (l == 0) {
      s2 = wave_sum(s2); const float r1 = rsqrtf(s2 * (1.f / 1024.f) + 1e-6f);
      bf16_t* H = (bf16_t*)(p.ws + OFF_H) + (size_t)row * D;
#pragma unroll
      for (int j = 0; j < 2; ++j) { u32x4 ob;
#pragma unroll
        for (int e = 0; e < 4; ++e) { const int c = lane * 8 + 512 * j + 2 * e;
          ob[e] = pk2(xv[rr][j * 8 + 2 * e] * r1 * p.in[10][1024 + c] * (1.f + mod1[1024 + c]) + mod1[c], xv[rr][j * 8 + 2 * e + 1] * r1 * p.in[10][1024 + c + 1] * (1.f + mod1[1024 + c + 1]) + mod1[c + 1]); }
        *(u32x4*)(H + lane * 8 + 512 * j) = ob; }
    }
  }
}

DI void task_fold(const Params& p, int t) {
  int l = t >> 5, mt = (t >> 2) & 7, ct = t & 3; f32x4 acc[4][4];
  LdPlain la{(const bf16_t*)(p.ws + OFF_WFU) + (size_t)l * 1024 * 256 + (size_t)mt * 128 * 256, 256};
  LdPlain lb{(const bf16_t*)(p.ws + OFF_M1T) + (size_t)l * 512 * 256 + (size_t)ct * 128 * 256, 256};
  gemm_core<false>(acc, la, lb, 4);
  stage_T(acc, [](int, float v) { return v; });
  store_img((bf16_t*)(p.ws + OFF_WIT) + (size_t)l * NIN * 1024 + (size_t)(2816 + ct * 128) * 1024 + mt * 128, 1024);
}
DI void task_inproj(const Params& p, int l, int t, int tnext, bf16x8 (&pra)[4], bf16x8 (&prb)[4]) {
  int mt = t / 28, ct = t % 28; int row0 = mt * 128; bool lat = mt >= 64; f32x4 acc[4][4];
  LdPlain la{(const bf16_t*)(p.ws + OFF_H) + (size_t)row0 * D, D};
  LdPlain lb{(const bf16_t*)(p.ws + OFF_WIT) + (size_t)l * NIN * 1024 + (size_t)ct * 128 * 1024, 1024};
  const bool ttile = (ct == 3 || ct == 10 || ct == 11 || (ct >= 14 && ct < 26));
  const int pos0 = lat ? ((row0 - MCTX) & 4095) : 0;
  char* ws = p.ws;
  const int b = row0 >> 8, t0 = row0 & 255; const size_t r128 = ((size_t)(b * 2 + l) * 256 + t0);
  const bf16_t* nA = nullptr; const bf16_t* nB = nullptr;
  if (tnext >= 0) { nA = (const bf16_t*)(p.ws + OFF_H) + (size_t)(tnext / 28) * 128 * D; nB = (const bf16_t*)(p.ws + OFF_WIT) + (size_t)l * NIN * 1024 + (size_t)(tnext % 28) * 128 * 1024; }
  if (ttile) {
    gemm_core_dma<false>(acc, la.p, D, lb.p, 1024, 16);
    if (!lat) {
      if (ct == 3) store_acc_f32<false>(acc, p.out + OUT_AV + r128 * 128, 128);
      else if (ct == 10 || ct == 11) store_acc_f32<false>(acc, p.out + OUT_DV + r128 * 256 + (ct - 10) * 128, 256);
    }
    if (ct == 20 || ct == 21) stage_T(acc, [](int, float v) { return silu(v); }); else stage_T(acc, [](int, float v) { return v; });
    if (ct == 3) store_img((bf16_t*)(ws + OFF_VAT) + row0, MTOT);
    else if (ct < 12) store_img((bf16_t*)(ws + OFF_VDT) + (size_t)(ct - 10) * 128 * MTOT + row0, MTOT);
    else if (ct < 20) store_img((bf16_t*)(ws + OFF_HUT) + (size_t)(ct - 14) * 128 * MTOT + row0, MTOT);
    else if (ct < 22) store_img((bf16_t*)(ws + OFF_HGT) + (size_t)(ct - 20) * 128 * MTOT + row0, MTOT);
    else store_img((bf16_t*)(ws + OFF_PT) + (size_t)(ct - 22) * 128 * MTOT + row0, MTOT);
  } else {
    gemm_core_dma<true>(acc, la.p, D, lb.p, 1024, 16);
    if (!lat) {
      if (ct == 2) store_acc_f32<true>(acc, p.out + OUT_AK + r128 * 128, 128);
      else if (ct == 8 || ct == 9) store_acc_f32<true>(acc, p.out + OUT_DK + r128 * 256 + (ct - 8) * 128, 256);
    }
    const bool gate = (ct == 4 || ct == 5 || ct == 12 || ct == 13 || ct >= 26);
    if (gate) stage_R(acc, [](int, float v) { return silu(v); }); else stage_R(acc, [](int, float v) { return v; });
    const float* cosA = (const float*)(ws + OFF_COSA); const float* sinA = (const float*)(ws + OFF_SINA); const float* cosD = (const float*)(ws + OFF_COSD); const float* sinD = (const float*)(ws + OFF_SIND);
    if (ct < 2) { bf16_t* d = (bf16_t*)(ws + OFF_QA) + (size_t)row0 * 256 + ct * 128; if (lat) store_rope<64>(d, 256, pos0, cosA, sinA); else store_img(d, 256); }
    else if (ct == 2) { bf16_t* d = (bf16_t*)(ws + OFF_KA) + (size_t)row0 * 128; if (lat) store_rope<64>(d, 128, pos0, cosA, sinA); else store_img(d, 128); }
    else if (ct < 6) store_img((bf16_t*)(ws + OFF_G) + (size_t)row0 * 768 + (ct - 4) * 128, 768);
    else if (ct < 8) { bf16_t* d = (bf16_t*)(ws + OFF_QD) + (size_t)row0 * 256 + (ct - 6) * 128; if (lat) store_rope<32>(d, 256, pos0, cosD, sinD); else store_img(d, 256); }
    else if (ct < 10) { bf16_t* d = (bf16_t*)(ws + OFF_KD) + (size_t)row0 * 256 + (ct - 8) * 128; if (lat) store_rope<32>(d, 256, pos0, cosD, sinD); else store_img(d, 256); }
    else if (ct < 14) store_img((bf16_t*)(ws + OFF_G) + (size_t)row0 * 768 + 256 + (ct - 12) * 128, 768);
    else store_img((bf16_t*)(ws + OFF_G) + (size_t)row0 * 768 + 512 + (ct - 26) * 128, 768);
  }
}
DI void task_outproj(const Params& p, int l, int t, int tnext, bf16x8 (&pra)[4], bf16x8 (&prb)[4]) {
  int mt = t >> 3, ct = t & 7; f32x4 acc[4][4];
  LdPlain la{(const bf16_t*)(p.ws + OFF_H) + (size_t)mt * 128 * D, D};
  LdPlain lb{(const bf16_t*)(p.ws + OFF_WOT) + (size_t)l * 1024 * 1024 + (size_t)ct * 128 * 1024, 1024};
  gemm_core_outproj(acc, la.p, D, lb.p, 1024, (const bf16_t*)(p.ws + OFF_HUT), mt * 128);
  stage_R(acc, [](int, float v) { return v; });
  store_img((bf16_t*)(p.ws + OFF_O) + (size_t)mt * 128 * D + ct * 128, D);
}
struct LdDft { const float* tab; int n, k; float ce[8], se[8];
  DI bf16x8 operator()(int, int kk) const { const int part = kk >= n; const int t = kk - (part ? n : 0);
    const int idx = (k * t) & (n - 1); const float ca = tab[idx], sa = tab[(idx - (n >> 2)) & (n - 1)];
    u32x4 o;
    if (!part) {
#pragma unroll
      for (int e = 0; e < 4; ++e) o[e] = pk2(ca * ce[2 * e] - sa * se[2 * e], ca * ce[2 * e + 1] - sa * se[2 * e + 1]);
    } else {
#pragma unroll
      for (int e = 0; e < 4; ++e) o[e] = pk2(-(sa * ce[2 * e] + ca * se[2 * e]), -(sa * ce[2 * e + 1] + ca * se[2 * e + 1]));
    }
    return __builtin_bit_cast(bf16x8, o); } };
struct LdPT { const bf16_t* base; int n;
  DI bf16x8 operator()(int row, int kk) const { int part = kk >= n; int t = kk - (part ? n : 0); return *(const bf16x8*)(base + (size_t)(part * 256 + row) * MTOT + t); } };
DI float dft_cos(const float* tab, int n, int idx) { idx &= (n - 1); return tab[min(idx, n - idx)]; }
DI void fnet_core(f32x4 (&acc)[4][4], const float* tab, int n, int krow, const float (&ce)[8], const float (&se)[8], const bf16_t* Bbase) {
  const int nk = 2 * n / 64;
  const int tid = otid(), lane = tid & 63, wid = tid >> 6, wr = wid >> 1, wc = wid & 1, fr = lane & 15, fq = lane >> 4;
#pragma unroll
  for (int i = 0; i < 4; ++i)
#pragma unroll
    for (int j = 0; j < 4; ++j) acc[i][j] = f32x4{0.f, 0.f, 0.f, 0.f};
  unsigned offb[4];
#pragma unroll
  for (int i = 0; i < 4; ++i) { const int L = (wid * 4 + i) * 64 + lane; const int row = L >> 3, pos = L & 7; const int c = pos ^ ((row >> 1) & 7); offb[i] = (unsigned)(row * MTOT + c * 8); }
  const int arow = tid >> 1;
  auto dmaB = [&](int st, int kt) { const int kk0 = kt * 64; const int part = kk0 >= n; const unsigned koff = (unsigned)(part * 256 * MTOT + kk0 - (part ? n : 0));
#pragma unroll
    for (int i = 0; i < 4; ++i)
      __builtin_amdgcn_global_load_lds((const unsigned*)(Bbase + offb[i] + koff), (LDS_AS unsigned*)(smem + st * 32768 + 16384 + (wid * 4 + i) * 1024), 16, 0, 0); };
  auto genA = [&](int st, int kt) { char* sA = smem + st * 32768; const int part = (kt * 64) >= n;
#pragma unroll
    for (int i = 0; i < 4; ++i) { const int chunk = (tid & 1) * 4 + i; const int t = kt * 64 + chunk * 8 - (part ? n : 0);
      const int idx = krow * t; const float ca = dft_cos(tab, n, idx), sa = dft_cos(tab, n, idx - (n >> 2));
      u32x4 o;
      if (!part) {
#pragma unroll
        for (int e = 0; e < 4; ++e) o[e] = pk2(ca * ce[2 * e] - sa * se[2 * e], ca * ce[2 * e + 1] - sa * se[2 * e + 1]);
      } else {
#pragma unroll
        for (int e = 0; e < 4; ++e) o[e] = pk2(-(sa * ce[2 * e] + ca * se[2 * e]), -(sa * ce[2 * e + 1] + ca * se[2 * e + 1]));
      }
      *(u32x4*)(sA + arow * 128 + ((chunk ^ ((arow >> 1) & 7)) * 16)) = o; } };
  auto comp = [&](int st) {
    const bf16_t* sA = (const bf16_t*)(smem + st * 32768); const bf16_t* sB = (const bf16_t*)(smem + st * 32768 + 16384);
#pragma unroll
    for (int ks = 0; ks < 2; ++ks) {
      bf16x8 a[4], b[4];
#pragma unroll
      for (int mi = 0; mi < 4; ++mi) a[mi] = *(const bf16x8*)(sA + (wr * 64 + mi * 16 + fr) * 64 + (((ks * 4 + fq) ^ ((fr >> 1) & 7)) * 8));
#pragma unroll
      for (int ni = 0; ni < 4; ++ni) b[ni] = *(const bf16x8*)(sB + (wc * 64 + ni * 16 + fr) * 64 + (((ks * 4 + fq) ^ ((fr >> 1) & 7)) * 8));
#pragma unroll
      for (int mi = 0; mi < 4; ++mi)
#pragma unroll
        for (int ni = 0; ni < 4; ++ni) acc[mi][ni] = mfma16(b[ni], a[mi], acc[mi][ni]);
    } };
  __syncthreads();
  dmaB(0, 0); genA(0, 0);
  asm volatile("s_waitcnt vmcnt(0)" ::: "memory");
  __syncthreads();
#pragma unroll 1
  for (int kt = 0; kt < nk; kt += 2) {
    dmaB(1, kt + 1); genA(1, kt + 1);
    comp(0);
    asm volatile("s_waitcnt vmcnt(0)" ::: "memory");
    __syncthreads();
    if (kt + 2 < nk) { dmaB(0, kt + 2); genA(0, kt + 2); }
    comp(1);
    asm volatile("s_waitcnt vmcnt(0)" ::: "memory");
    __syncthreads();
  }
}
DI void task_fnet(const Params& p, int l, int set, int t) {
  int n = set ? 4096 : 256; int ct = t & 1, rt = set ? (t >> 1) & 31 : (t >> 1) & 1, b = set ? t >> 6 : t >> 2;
  int tokbase = set ? MCTX + b * 4096 : b * 256;
  float* tab = (float*)(smem + 65536);
  __syncthreads();
  for (int i = otid(); i <= n / 2; i += 256) tab[i] = cospif(2.f * (float)i / (float)n);
  __syncthreads();
  f32x4 acc[4][4];
  const int krow = rt * 128 + (otid() >> 1); float ce[8], se[8];
#pragma unroll
  for (int e = 0; e < 8; ++e) { ce[e] = dft_cos(tab, n, krow * e); se[e] = dft_cos(tab, n, krow * e - (n >> 2)); }
  fnet_core(acc, tab, n, krow, ce, se, (const bf16_t*)(p.ws + OFF_PT) + (size_t)ct * 128 * MTOT + tokbase);
  float scale = rsqrtf(64.f * (float)n); const float* fb = p.in[27] + l * 256 + ct * 128;
  stage_R(acc, [=](int col, float v) { return v * scale + fb[col]; });
  const bf16_t* sC = (const bf16_t*)smem; const int tid = otid();
  const bf16_t* g = (const bf16_t*)(p.ws + OFF_G) + (size_t)(tokbase + rt * 128) * 768 + 512 + ct * 128;
  bf16_t* dst = (bf16_t*)(p.ws + OFF_H) + (size_t)(tokbase + rt * 128) * D + 768 + ct * 128;
#pragma unroll
  for (int i = 0; i < 8; ++i) { const int id = tid + i * 256; const int r = id >> 4, c = (id & 15) * 8;
    const bf16x8 v = *(const bf16x8*)(sC + r * 136 + c), gg = *(const bf16x8*)(g + (size_t)r * 768 + c); u32x4 o;
#pragma unroll
    for (int e = 0; e < 4; ++e) o[e] = pk2(bf2f((bf16_t)v[2 * e]) * bf2f((bf16_t)gg[2 * e]), bf2f((bf16_t)v[2 * e + 1]) * bf2f((bf16_t)gg[2 * e + 1]));
    *(u32x4*)(dst + (size_t)r * D + c) = o; }
}

DI bf16x8 vt_frag(const bf16_t* Vt, size_t ldv, int dt, int s2, int r, int h) {
  const bf16_t* vp = Vt + (size_t)(dt * 32 + r) * ldv + 16 * s2 + 4 * h;
  s16x4 lo = *(const s16x4*)vp, hi = *(const s16x4*)(vp + 8);
  return __builtin_shufflevector(lo, hi, 0, 1, 2, 3, 4, 5, 6, 7);
}
template <bool DIFF>
DI void task_attn(const Params& p, int l, int set, int b, int head, int qb) {
  constexpr int NM = DIFF ? 2 : 1, KS = DIFF ? 2 : 4, LDK = DIFF ? 256 : 128, VCH = DIFF ? 256 : 128;
  const int tid = otid(), lane = tid & 63, w = tid >> 6, r = lane & 31, h = lane >> 5;
  const int n = set ? 4096 : 256, tokbase = set ? MCTX + b * 4096 : b * 256, q0 = qb * 128 + w * 32;
  const int hoffq = DIFF ? head * 32 : head * 64, hoffk = DIFF ? head * 32 : (head >> 1) * 64, vch = DIFF ? head * 64 : (head >> 1) * 64;
  const bf16_t* Q = (const bf16_t*)(p.ws + (DIFF ? OFF_QD : OFF_QA));
  const bf16_t* K1 = (const bf16_t*)(p.ws + (DIFF ? OFF_KD : OFF_KA)); const bf16_t* V1 = (const bf16_t*)(p.ws + (DIFF ? OFF_VDT : OFF_VAT));
  const bf16_t* K2 = (const bf16_t*)(p.ws + (DIFF ? OFF_KCD : OFF_KCA)) + (size_t)(b * 2 + l) * 512 * LDK + hoffk;
  const bf16_t* V2 = (const bf16_t*)(p.ws + (DIFF ? OFF_VCDT : OFF_VCAT)) + ((size_t)(b * 2 + l) * VCH + vch) * 512;
  int tile0 = 0, nt1 = n >> 7;
  if (!DIFF && set) { tile0 = max(0, qb - 1); nt1 = min(31, qb + 1) - tile0 + 1; }
  const int ntt = nt1 + (set ? 4 : 0);
  bf16_t* sK = (bf16_t*)smem; bf16_t* sV = (bf16_t*)(smem + 18432);
  bf16x8 qf[NM][KS];
#pragma unroll
  for (int mm = 0; mm < NM; ++mm)
#pragma unroll
    for (int ks = 0; ks < KS; ++ks) qf[mm][ks] = *(const bf16x8*)(Q + (size_t)(tokbase + q0 + r) * 256 + mm * 128 + hoffq + ks * 16 + 8 * h);
  const float c = (DIFF ? 0.17677669529663687f : 0.125f) * 1.4426950408889634f;
  float m[NM], ls[NM]; f32x16 O[NM][2];
#pragma unroll
  for (int mm = 0; mm < NM; ++mm) {
    if (DIFF) { m[mm] = -1e30f; ls[mm] = 0.f; } else { m[mm] = p.in[14][l * 4 + head] * 1.4426950408889634f; ls[mm] = h == 0 ? 1.f : 0.f; }
#pragma unroll
    for (int dt = 0; dt < 2; ++dt) for (int i = 0; i < 16; ++i) O[mm][dt][i] = 0.f;
  }
  auto gload = [&](int ti, bf16x8 (&kr)[4], bf16x8 (&vr)[4]) {
    const bf16_t* kb; const bf16_t* vb; size_t ldv;
    if (ti < nt1) { const int n0 = (tile0 + ti) * 128; kb = K1 + (size_t)(tokbase + n0) * LDK + hoffk; vb = V1 + (size_t)vch * MTOT + tokbase + n0; ldv = MTOT; }
    else { const int n0 = (ti - nt1) * 128; kb = K2 + (size_t)n0 * LDK; vb = V2 + n0; ldv = 512; }
#pragma unroll
    for (int i = 0; i < 4; ++i) { const int id = tid + i * 256; const int key = id >> 3, cc = id & 7; const int coff = DIFF ? ((cc >> 2) * 128 + (cc & 3) * 8) : cc * 8;
      kr[i] = *(const bf16x8*)(kb + (size_t)key * LDK + coff);
      const int d = id >> 4, c2 = id & 15; vr[i] = *(const bf16x8*)(vb + (size_t)d * ldv + c2 * 8); }
  };
  auto compute = [&](int ti, int sub) {
    bool masked = false; int nbase = 0;
    if (!DIFF && set && ti < nt1) { nbase = (tile0 + ti) * 128 + sub * 32; if (nbase + 31 < q0 - 128 || nbase > q0 + 159) return; masked = true; }
    bf16x8 vf[2][2];
#pragma unroll
    for (int dt = 0; dt < 2; ++dt)
#pragma unroll
      for (int s2 = 0; s2 < 2; ++s2) { const bf16_t* vp = sV + (dt * 32 + r) * 132 + sub * 32 + 16 * s2 + 4 * h; s16x4 lo = *(const s16x4*)vp, hi = *(const s16x4*)(vp + 8);
        vf[dt][s2] = __builtin_shufflevector(lo, hi, 0, 1, 2, 3, 4, 5, 6, 7); }
#pragma unroll
    for (int mm = 0; mm < NM; ++mm) {
      f32x16 s;
#pragma unroll
      for (int i = 0; i < 16; ++i) s[i] = 0.f;
#pragma unroll
      for (int ks = 0; ks < KS; ++ks) { bf16x8 kf = *(const bf16x8*)(sK + (sub * 32 + r) * 72 + (DIFF ? mm * 32 : 0) + ks * 16 + 8 * h); s = mfma32(kf, qf[mm][ks], s); }
      if (masked) {
        const int dq = q0 + r - nbase - 4 * h;
#pragma unroll
        for (int i = 0; i < 16; ++i) { int dd = dq - ((i & 3) + 8 * (i >> 2)); if (dd > 128 || dd < -128) s[i] = -1e30f; }
      }
      float mx = fmaxf(fmaxf(s[0], s[1]), s[2]);
#pragma unroll
      for (int i = 3; i < 15; i += 2) mx = fmaxf(fmaxf(mx, s[i]), s[i + 1]);
      mx = fmaxf(mx, s[15]);
      {
        auto rr = __builtin_amdgcn_permlane32_swap(__float_as_uint(mx), __float_as_uint(mx), false, false);
        mx = fmaxf(__uint_as_float(rr[0]), __uint_as_float(rr[1])); }
      const float mxs = mx * c;
      if (__any(mxs - m[mm] > 8.f)) {
        const float mn2 = fmaxf(m[mm], mxs);
        const float alpha = __builtin_amdgcn_exp2f(m[mm] - mn2); ls[mm] *= alpha;
#pragma unroll
        for (int dt = 0; dt < 2; ++dt)
#pragma unroll
          for (int i = 0; i < 16; ++i) O[mm][dt][i] *= alpha;
        m[mm] = mn2;
      }
      const float mn = m[mm]; float sum = 0.f;
#pragma unroll
      for (int i = 0; i < 16; ++i) { float pe = __builtin_amdgcn_exp2f(__builtin_fmaf(s[i], c, -mn)); s[i] = pe; sum += pe; }
      ls[mm] += sum;
      bf16x8 pf[2];
#pragma unroll
      for (int s2 = 0; s2 < 2; ++s2) { u32x4 u;
#pragma unroll
        for (int j = 0; j < 4; ++j) u[j] = pk2(s[8 * s2 + 2 * j], s[8 * s2 + 2 * j + 1]);
        pf[s2] = __builtin_bit_cast(bf16x8, u); }
#pragma unroll
      for (int dt = 0; dt < 2; ++dt)
#pragma unroll
        for (int s2 = 0; s2 < 2; ++s2) O[mm][dt] = mfma32(vf[dt][s2], pf[s2], O[mm][dt]);
    }
  };
  {
    bf16x8 kr[4], vr[4];
    gload(0, kr, vr);
    for (int ti = 0; ti < ntt; ++ti) {
      __syncthreads();
#pragma unroll
      for (int i = 0; i < 4; ++i) { const int id = tid + i * 256; *(bf16x8*)(sK + (id >> 3) * 72 + (id & 7) * 8) = kr[i]; { bf16_t* vd = sV + (id >> 4) * 132 + (id & 15) * 8; const s16x4 vlo = __builtin_shufflevector(vr[i], vr[i], 0, 1, 2, 3), vhi = __builtin_shufflevector(vr[i], vr[i], 4, 5, 6, 7); *(s16x4*)vd = vlo; *(s16x4*)(vd + 4) = vhi; } }
      __syncthreads();
      if (ti + 1 < ntt) gload(ti + 1, kr, vr);
      __builtin_amdgcn_sched_barrier(0);
#pragma unroll 2
      for (int sub = 0; sub < 4; ++sub) compute(ti, sub);
    }
    __syncthreads();
  }
  const int tok = tokbase + q0 + r;
  if (!DIFF) {
    float lt = ls[0] + __shfl_xor(ls[0], 32); float inv = 1.f / lt;
    const bf16_t* G = (const bf16_t*)(p.ws + OFF_G) + (size_t)tok * 768 + head * 64; bf16_t* dst = (bf16_t*)(p.ws + OFF_H) + (size_t)tok * D + head * 64;
#pragma unroll
    for (int dt = 0; dt < 2; ++dt)
#pragma unroll
      for (int g4 = 0; g4 < 4; ++g4) { int d = dt * 32 + 8 * g4 + 4 * h; s16x4 gg = *(const s16x4*)(G + d), o;
#pragma unroll
        for (int e = 0; e < 4; ++e) o[e] = (short)f2bf(O[0][dt][4 * g4 + e] * inv * bf2f((bf16_t)gg[e]));
        *(s16x4*)(dst + d) = o; }
  } else {
    const float* lp = p.in[15] + l * 128; float d01 = 0, d23 = 0;
    for (int i = 0; i < 32; ++i) { d01 += lp[i] * lp[32 + i]; d23 += lp[64 + i] * lp[96 + i]; }
    const float lam_init = 0.8f - 0.6f * expf(-0.3f * (float)l); const float lam = expf(d01) - expf(d23) + lam_init;
    float l0 = ls[0] + __shfl_xor(ls[0], 32), l1 = ls[NM - 1] + __shfl_xor(ls[NM - 1], 32);
    float i0 = 1.f / l0, i1 = lam / l1, ss = 0;
#pragma unroll
    for (int dt = 0; dt < 2; ++dt)
#pragma unroll
      for (int i = 0; i < 16; ++i) { float o = O[0][dt][i] * i0 - O[NM - 1][dt][i] * i1; O[0][dt][i] = o; ss += o * o; }
    ss += __shfl_xor(ss, 32); float rn = rsqrtf(ss * (1.f / 64.f) + 1e-6f) * (1.f - lam_init);
    const float* sub = p.in[16] + l * 64;
    const bf16_t* G = (const bf16_t*)(p.ws + OFF_G) + (size_t)tok * 768 + 256 + head * 64; bf16_t* dst = (bf16_t*)(p.ws + OFF_H) + (size_t)tok * D + 256 + head * 64;
#pragma unroll
    for (int dt = 0; dt < 2; ++dt)
#pragma unroll
      for (int g4 = 0; g4 < 4; ++g4) { int d = dt * 32 + 8 * g4 + 4 * h; s16x4 gg = *(const s16x4*)(G + d), o;
#pragma unroll
        for (int e = 0; e < 4; ++e) o[e] = (short)f2bf(O[0][dt][4 * g4 + e] * rn * sub[d + e] * bf2f((bf16_t)gg[e]));
        *(s16x4*)(dst + d) = o; }
  }
}

template <int SET>
DI void task_hyena(const Params& p, int l, int c) {
  constexpr int n = SET ? 4096 : 256, NB = SET ? 4 : 32, PAD = SET ? 1024 : 256, ZP = SET ? 6144 : 768, ZOFF = SET ? 16512 : 1152, ZPP = ZP * 5 / 4, NT = SET ? 4 : 2;
  const int tid = otid(), lane = tid & 63, w = tid >> 6, r = lane & 31, h = lane >> 5;
  bf16_t* kr = (bf16_t*)smem;
  bf16_t* zs = (bf16_t*)(smem + ZOFF);
  float* red = (float*)(smem + ZOFF + NB * ZPP * 2);
  const bf16_t* F = (const bf16_t*)(p.ws + OFF_FILT) + (size_t)l * FILT_L + (SET ? 512 * 256 : 0);
  const bf16_t* hf = F + (size_t)c * n; const bf16_t* hb = F + (size_t)(256 + c) * n;
  const bf16_t* HuT = (const bf16_t*)(p.ws + OFF_HUT);
  __syncthreads();
  constexpr int NC = n / 8, CH = (NC + 255) / 256;
  bf16x8 fh[CH], fb[CH]; float s = 0;
#pragma unroll
  for (int k = 0; k < CH; ++k) { const int ci = tid + k * 256;
    if (ci < NC) { fh[k] = *(const bf16x8*)(hf + ci * 8); fb[k] = *(const bf16x8*)(hb + ci * 8);
#pragma unroll
      for (int e = 0; e < 8; ++e) s += fabsf(bf2f((bf16_t)fh[k][e])) + fabsf(bf2f((bf16_t)fb[k][e])); } }
  { bf16x8 zz = {0, 0, 0, 0, 0, 0, 0, 0}; for (int i = tid; i < NB * ZPP / 8; i += 256) *(bf16x8*)(zs + i * 8) = zz; }
  s = wave_sum(s); if (lane == 0) red[w] = s;
  __syncthreads();
  const float inv = 1.f / (red[0] + red[1] + red[2] + red[3] + 1e-6f); const float skip = p.in[25][l * 256 + c];
#pragma unroll
  for (int k = 0; k < CH; ++k) { const int ci = tid + k * 256;
    if (ci < NC) {
#pragma unroll
      for (int e = 0; e < 8; ++e) { const int d = ci * 8 + e; float v = bf2f((bf16_t)fh[k][e]) * inv; if (d == 0) v += skip; kr[n + d] = f2bf(v);
        if (d > 0) kr[n - d] = f2bf(bf2f((bf16_t)fb[k][e]) * inv); } } }
  if (tid < 33) kr[tid == 32 ? 0 : 2 * n + tid] = 0;
  const float* cw = p.in[17] + l * 3 * 768; const float* cb = p.in[18] + l * 768;
  const float w10 = cw[256 + c], w11 = cw[768 + 256 + c], w12 = cw[1536 + 256 + c], b1 = cb[256 + c];
  const float w20 = cw[512 + c], w21 = cw[768 + 512 + c], w22 = cw[1536 + 512 + c], b2 = cb[512 + c];
  const float w00 = cw[c], w01 = cw[768 + c], w02 = cw[1536 + c], b0 = cb[c];
  const int tb0 = SET ? MCTX : 0;
  constexpr int CHZ = NB * NC / 256;
  const bf16_t* U1 = HuT + (size_t)(256 + c) * MTOT + tb0; const bf16_t* U2 = HuT + (size_t)(512 + c) * MTOT + tb0;
#pragma unroll
  for (int k = 0; k < CHZ; ++k) { const int ci = tid + k * 256; const int b = ci / NC, s0 = (ci - b * NC) * 8; const int off = b * n + s0;
    const bf16x8 c1 = *(const bf16x8*)(U1 + off), c2 = *(const bf16x8*)(U2 + off);
    const float p1 = s0 > 0 ? bf2f(U1[off - 1]) : 0.f, n1 = s0 + 8 < n ? bf2f(U1[off + 8]) : 0.f;
    const float p2 = s0 > 0 ? bf2f(U2[off - 1]) : 0.f, n2 = s0 + 8 < n ? bf2f(U2[off + 8]) : 0.f;
    float x1[10], x2[10]; x1[0] = p1; x2[0] = p2; x1[9] = n1; x2[9] = n2;
#pragma unroll
    for (int e = 0; e < 8; ++e) { x1[e + 1] = bf2f((bf16_t)c1[e]); x2[e + 1] = bf2f((bf16_t)c2[e]); }
    u32x4 zo;
#pragma unroll
    for (int e = 0; e < 4; ++e) {
      float za = (x1[2 * e] * w10 + x1[2 * e + 1] * w11 + x1[2 * e + 2] * w12 + b1) * (x2[2 * e] * w20 + x2[2 * e + 1] * w21 + x2[2 * e + 2] * w22 + b2);
      float zb2 = (x1[2 * e + 1] * w10 + x1[2 * e + 2] * w11 + x1[2 * e + 3] * w12 + b1) * (x2[2 * e + 1] * w20 + x2[2 * e + 2] * w21 + x2[2 * e + 3] * w22 + b2);
      zo[e] = pk2(za, zb2); }
    const int sp = PAD + s0;
    *(u32x4*)(zs + b * ZPP + sp + 8 * (sp >> 5)) = zo; }
  __syncthreads();
  f32x16 acc[NT];
#pragma unroll
  for (int j = 0; j < NT; ++j) for (int i = 0; i < 16; ++i) acc[j][i] = 0.f;
  constexpr int DMIN = SET ? -255 : -15, DMAX = SET ? 254 : 14;
  auto buildA = [&](int dl) { bf16x8 a; const int base = n + 16 * dl + r - 8 * h;
#pragma unroll
    for (int e = 0; e < 8; ++e) a[e] = (short)kr[base - e];
    return a; };
  auto tvalid = [&](int dl, int j) { return SET ? (dl >= 64 * j - 255 && dl <= 64 * j + 62) : true; };
  auto loadB = [&](int dl, bf16x8 (&bz)[NT]) {
#pragma unroll
    for (int j = 0; j < NT; ++j) {
      int zb, sp;
      if (SET) { zb = w; sp = PAD + 1024 * j + 32 * r - 16 * dl + 8 * h; }
      else { zb = 8 * w + 4 * j + (r >> 3); sp = PAD + 32 * (r & 7) - 16 * dl + 8 * h; }
      const int off = tvalid(dl, j) ? zb * ZPP + sp + 8 * (sp >> 5) : 0;
      bz[j] = *(const bf16x8*)(zs + off);
    } };
  bf16x8 a_cur = buildA(DMIN), bz_cur[NT];
  loadB(DMIN, bz_cur);
#pragma unroll 1
  for (int dl = DMIN; dl <= DMAX; dl += 2) {
    bf16x8 bz_nx[NT];
    const bf16x8 a_nx = buildA(dl + 1);
    loadB(dl + 1, bz_nx);
#pragma unroll
    for (int j = 0; j < NT; ++j) if (tvalid(dl, j)) acc[j] = mfma32(a_cur, bz_cur[j], acc[j]);
    a_cur = buildA(dl + 2);
    loadB(dl + 2, bz_cur);
#pragma unroll
    for (int j = 0; j < NT; ++j) if (tvalid(dl + 1, j)) acc[j] = mfma32(a_nx, bz_nx[j], acc[j]);
  }
  __syncthreads();
  constexpr int YP = n + n / 16;
  bf16_t* yb = zs;
#pragma unroll
  for (int j = 0; j < NT; ++j)
#pragma unroll
    for (int i = 0; i < 16; ++i) {
      int b, t;
      if (SET) { b = w; t = 1024 * j + 32 * r + crow(i, h); } else { b = 8 * w + 4 * j + (r >> 3); t = 32 * (r & 7) + crow(i, h); }
      yb[b * YP + t + 2 * (t >> 5)] = f2bf(acc[j][i]);
    }
  __syncthreads();
  const bf16_t* u0 = HuT + (size_t)c * MTOT + tb0; const bf16_t* HgT = (const bf16_t*)(p.ws + OFF_HGT) + (size_t)c * MTOT + tb0;
  bf16_t* dst = (bf16_t*)(p.ws + OFF_HUT) + (size_t)c * MTOT + tb0;
  bf16x8 cu[CHZ], cgt[CHZ]; float pu[CHZ], nu[CHZ];
#pragma unroll
  for (int k = 0; k < CHZ; ++k) { const int ci = tid + k * 256; const int b = ci / NC, t0 = (ci - b * NC) * 8; const int off = b * n + t0;
    cu[k] = *(const bf16x8*)(u0 + off); cgt[k] = *(const bf16x8*)(HgT + off);
    pu[k] = t0 > 0 ? bf2f(u0[off - 1]) : 0.f; nu[k] = t0 + 8 < n ? bf2f(u0[off + 8]) : 0.f; }
  __syncthreads();
#pragma unroll
  for (int k = 0; k < CHZ; ++k) { const int ci = tid + k * 256; const int b = ci / NC, t0 = (ci - b * NC) * 8; const int off = b * n + t0;
    float x[10]; x[0] = pu[k]; x[9] = nu[k];
#pragma unroll
    for (int e = 0; e < 8; ++e) x[e + 1] = bf2f((bf16_t)cu[k][e]);
    const bf16_t* yp = yb + b * YP + t0 + 2 * (t0 >> 5);
    u32x4 o;
#pragma unroll
    for (int e = 0; e < 4; ++e) {
      const float x0a = x[2 * e] * w00 + x[2 * e + 1] * w01 + x[2 * e + 2] * w02 + b0, x0b = x[2 * e + 1] * w00 + x[2 * e + 2] * w01 + x[2 * e + 3] * w02 + b0;
      o[e] = pk2(x0a * bf2f(yp[2 * e]) * bf2f((bf16_t)cgt[k][2 * e]), x0b * bf2f(yp[2 * e + 1]) * bf2f((bf16_t)cgt[k][2 * e + 1])); }
    *(u32x4*)(dst + off) = o; }
}

#define XB_TMO      128
#define XB_XCNT(j)  (256  + 64 * (j))
#define XB_XSUB(j)  (1280 + 64 * (j))
#define XB_XGEN(j)  (2304 + 64 * (j))
#define XB_TOP      3328
#define XB_TOPGEN   3392
#define XCD_BAR_WORDS 3456
#define XB_SPIN_CAP (1u << 18)
#define LAS __attribute__((address_space(3)))

__device__ __forceinline__ unsigned xb_ld(unsigned* p)              { return __hip_atomic_load(p, __ATOMIC_RELAXED, __HIP_MEMORY_SCOPE_AGENT); }
__device__ __forceinline__ unsigned xb_add(unsigned* p, unsigned v) { return __hip_atomic_fetch_add(p, v, __ATOMIC_RELAXED, __HIP_MEMORY_SCOPE_AGENT); }
__device__ __forceinline__ unsigned xb_xcc_id() { return (unsigned)__builtin_amdgcn_s_getreg((3 << 11) | 20) & 0xFu; }
#define XB_SPIN(cond, bar) do { unsigned _sp = 0; while (cond) { __builtin_amdgcn_s_sleep(1); \
    if ((++_sp & 255u) == 0u) { if (xb_ld(&(bar)[XB_TMO])) break; if (_sp > XB_SPIN_CAP) { atomicAdd(&(bar)[XB_TMO], 1u); break; } } } } while (0)

struct XcdBarrier {
    unsigned* bar; unsigned x;
    volatile LAS unsigned* st;
};

__device__ __forceinline__ XcdBarrier xcd_barrier_post(unsigned* bar, volatile LAS unsigned* st) {
    XcdBarrier b; b.bar = bar; b.x = xb_xcc_id(); b.st = st;
    if (threadIdx.x == 0) (void)xb_add(&bar[XB_XCNT(b.x)], 1u);
    return b;
}
__device__ __forceinline__ void xcd_barrier_complete(unsigned* bar, unsigned x, unsigned& nloc, unsigned& nx) {
    const unsigned G = gridDim.x * gridDim.y * gridDim.z;
    unsigned sum, cnt, mine, sp = 0u;
    for (;;) {
        sum = 0u; cnt = 0u; mine = 0u;
#pragma unroll
        for (unsigned j = 0; j < 16; ++j) { const unsigned c = xb_ld(&bar[XB_XCNT(j)]); sum += c; cnt += (c > 0u) ? 1u : 0u; mine = (j == x) ? c : mine; }
        if (sum == G) break;
        __builtin_amdgcn_s_sleep(1);
        if ((++sp & 255u) == 0u) { if (xb_ld(&bar[XB_TMO])) break; if (sp > XB_SPIN_CAP) { atomicAdd(&bar[XB_TMO], 1u); break; } }
    }
    nloc = mine > 0u ? mine : 1u; nx = cnt > 0u ? cnt : 1u;
}

__device__ __forceinline__ void xcd_barrier(const XcdBarrier& b) {
    asm volatile("s_waitcnt vmcnt(0)" ::: "memory");
    __syncthreads();
    if (threadIdx.x == 0) {
        unsigned* bar = b.bar;
        __builtin_amdgcn_s_waitcnt(0);
        unsigned nloc = b.st[0], nx = b.st[1];
        if (nloc == 0u) { xcd_barrier_complete(bar, b.x, nloc, nx); b.st[0] = nloc; b.st[1] = nx; }
        const unsigned old = xb_add(&bar[XB_XSUB(b.x)], 1u);
        const unsigned gen = old / nloc;
        if (old + 1u == (gen + 1u) * nloc) {
            __builtin_amdgcn_fence(__ATOMIC_RELEASE, "agent");
            asm volatile("s_waitcnt vmcnt(0)" ::: "memory");
            const unsigned og = xb_add(&bar[XB_TOP], 1u);
            const unsigned tg = og / nx;
            if (og + 1u == (tg + 1u) * nx) xb_add(&bar[XB_TOPGEN], 1u);
            else XB_SPIN(xb_ld(&bar[XB_TOPGEN]) == tg, bar);
            __builtin_amdgcn_fence(__ATOMIC_ACQUIRE, "agent");
            xb_add(&bar[XB_XGEN(b.x)], 1u);
            asm volatile("s_waitcnt vmcnt(0)" ::: "memory");
        } else {
            XB_SPIN(xb_ld(&bar[XB_XGEN(b.x)]) == gen, bar);
            __builtin_amdgcn_fence(__ATOMIC_ACQUIRE, "agent");
            asm volatile("s_waitcnt vmcnt(0)" ::: "memory");
        }
    }
    __syncthreads();
}

DI void run_phase(const Params& p, int ph) {
  const int bid = blockIdx.x, G = gridDim.x;
  if (ph == 0) {
    const int NTASK = 272 + 192 + 416 + 128 + 512 + 256;
    for (int t = bid; t < NTASK; t += G) {
      if (t < 272) task_filter(p, t);
      else if (t < 464) task_mod(p, t - 272);
      else if (t < 880) task_win(p, t - 464);
      else if (t < 1008) task_wout(p, t - 880);
      else if (t < 1520) task_m1(p, t - 1008);
      else task_elem(p, t - 1520, 256);
    }
  } else if (ph == 1) {
    for (int t = bid; t < 64 + MTOT / 4; t += G) { if (t < 64) task_fold(p, t); else task_prep(p, (t - 64) * 4 + (otid() >> 6)); }
  } else {
    const int l = (ph - 2) >> 2, sub = (ph - 2) & 3;
    if (sub == 0) {
      bf16x8 pra[4], prb[4];
      if ((G & 7) == 0) {
        const int x = bid & 7, jb = bid >> 3, nbx = G >> 3;
        auto tile_of = [&](int j) { const int sidx = j / 56, within = j - sidx * 56; const int mg = x + 8 * (sidx >> 2), cg = sidx & 3; return (mg * 8 + within / 7) * 28 + cg * 7 + within % 7; };
        int j = jb;
        if (j < 672) { const int t = tile_of(j); gemm_prefetch((const bf16_t*)(p.ws + OFF_H) + (size_t)(t / 28) * 128 * D, D, (const bf16_t*)(p.ws + OFF_WIT) + (size_t)l * NIN * 1024 + (size_t)(t % 28) * 128 * 1024, 1024, pra, prb); }
        for (; j < 672; j += nbx) task_inproj(p, l, tile_of(j), j + nbx < 672 ? tile_of(j + nbx) : -1, pra, prb);
      } else {
        int t = bid;
        if (t < 192 * 28) gemm_prefetch((const bf16_t*)(p.ws + OFF_H) + (size_t)(t / 28) * 128 * D, D, (const bf16_t*)(p.ws + OFF_WIT) + (size_t)l * NIN * 1024 + (size_t)(t % 28) * 128 * 1024, 1024, pra, prb);
        for (; t < 192 * 28; t += G) task_inproj(p, l, t, t + G < 192 * 28 ? t + G : -1, pra, prb);
      }
    }
    else if (sub == 1) {
      unsigned* ctr = (unsigned*)(p.ws + OFF_BAR) + XCD_BAR_WORDS + 64 * l;
      int* tslot = (int*)(smem + 81888);
      for (;;) {
        __syncthreads();
        if (otid() == 0) *tslot = (int)atomicAdd(ctr, 1u);
        __syncthreads();
        const int t = *tslot;
        if (t >= 2432) break;
        if (t < 512) { task_attn<true>(p, l, 1, t >> 7, (t >> 5) & 3, t & 31); }
        else if (t < 768) task_fnet(p, l, 1, t - 512);
        else if (t < 1024) task_hyena<1>(p, l, t - 768);
        else if (t < 1536) { int u = t - 1024; task_attn<false>(p, l, 1, u >> 7, (u >> 5) & 3, u & 31); }
        else if (t < 1792) { int u = t - 1536; task_attn<true>(p, l, 0, u >> 3, (u >> 1) & 3, u & 1); }
        else if (t < 2048) { int u = t - 1792; task_attn<false>(p, l, 0, u >> 3, (u >> 1) & 3, u & 1); }
        else if (t < 2304) task_hyena<0>(p, l, t - 2048);
        else task_fnet(p, l, 0, t - 2304);
      }
    }
    else if (sub == 2) {
      bf16x8 pra[4], prb[4];
      if ((G & 7) == 0) {
        const int x = bid & 7, jb = bid >> 3, nbx = G >> 3;
        auto tile_of = [&](int j) { const int sidx = j >> 6, within = j & 63; return ((x + 8 * sidx) * 8 + (within >> 3)) * 8 + (within & 7); };
        int j = jb;
        if (j < 192) { const int t = tile_of(j); gemm_prefetch((const bf16_t*)(p.ws + OFF_H) + (size_t)(t >> 3) * 128 * D, D, (const bf16_t*)(p.ws + OFF_WOT) + (size_t)l * 1024 * 1024 + (size_t)(t & 7) * 128 * 1024, 1024, pra, prb); }
        for (; j < 192; j += nbx) task_outproj(p, l, tile_of(j), j + nbx < 192 ? tile_of(j + nbx) : -1, pra, prb);
      } else {
        int t = bid;
        if (t < 192 * 8) gemm_prefetch((const bf16_t*)(p.ws + OFF_H) + (size_t)(t >> 3) * 128 * D, D, (const bf16_t*)(p.ws + OFF_WOT) + (size_t)l * 1024 * 1024 + (size_t)(t & 7) * 128 * 1024, 1024, pra, prb);
        for (; t < 192 * 8; t += G) task_outproj(p, l, t, t + G < 192 * 8 ? t + G : -1, pra, prb);
      }
    }
    else { for (int t = bid; t < MTOT / 8; t += G) task_final(p, l, t * 8 + (otid() >> 6) * 2); }
  }
}

__global__ void __launch_bounds__(256, 2) mega(Params p, int ph_lo, int ph_hi) {
  cg::grid_group grid = cg::this_grid();
  uint4* xb_words = (uint4*)(smem + 81904);
  if (threadIdx.x == 0) *xb_words = make_uint4(0u, 0u, 0u, 0u);
  __syncthreads();
  XcdBarrier xb = xcd_barrier_post((unsigned*)(p.ws + OFF_BAR), (volatile LAS unsigned*)xb_words);
  for (int ph = ph_lo; ph < ph_hi; ++ph) {
#ifdef REP_MASK
    if ((REP_MASK >> ph) & 1) run_phase(p, ph);
#endif
    run_phase(p, ph);
    if (ph + 1 < ph_hi) { if (ph_hi > 1000) grid.sync(); else xcd_barrier(xb); }
  }
}

extern "C" void kernel_launch(void* const* d_in, const int* in_sizes, int n_in, void* d_out, int out_size, void* d_ws, size_t ws_size, hipStream_t stream) {
  static int grid_blocks = 0;
  if (!grid_blocks) {
    int dev = 0, cus = 0, per_cu = 0; hipGetDevice(&dev);
    hipDeviceGetAttribute(&cus, hipDeviceAttributeMultiprocessorCount, dev);
    hipOccupancyMaxActiveBlocksPerMultiprocessor(&per_cu, mega, 256, 0);
    if (per_cu > 2) per_cu = 2;
    grid_blocks = cus * per_cu;
  }
  Params p{};
  for (int i = 0; i < 28; ++i) p.in[i] = (const float*)d_in[i];
  p.out = (float*)d_out; p.ws = (char*)d_ws;
#if MULTI_LAUNCH
  for (int ph = 0; ph < 10; ++ph) { int lo = ph, hi = ph + 1; hipLaunchKernelGGL(mega, dim3(grid_blocks), dim3(256), 0, stream, p, lo, hi); }
#else
  hipMemsetAsync((char*)d_ws + OFF_BAR, 0, (XCD_BAR_WORDS + 256) * sizeof(unsigned), stream);
  int lo = 0, hi = 10; void* args[] = {&p, &lo, &hi};
  hipError_t e = hipLaunchCooperativeKernel((void*)mega, dim3(grid_blocks), dim3(256), args, 0, stream);
  if (e != hipSuccess) fprintf(stderr, "cooperative launch failed: %s (grid %d)\n", hipGetErrorString(e), grid_blocks);
#endif
}
```
